# Optimizing an MI355X kernel written in HIP

```python
import math
import jax, jax.numpy as jnp
from jax import lax
import numpy as np

D_MODEL = 1024
BATCH = 16
SEQ = 2048
DEPTH = 2

N_META = 16
MIX_WIDTH = D_MODEL
FOX_WIDTH = MIX_WIDTH // 2
RET_WIDTH = MIX_WIDTH - FOX_WIDTH
FOX_HEAD_DIM = 64
FOX_HEADS = FOX_WIDTH // FOX_HEAD_DIM
RET_HEADS = 4
RET_HEAD_DIM = RET_WIDTH // RET_HEADS
D_FF = -(-8 * D_MODEL // (3 * 256)) * 256
BLOCK_Q = 128
RET_CHUNK = 128
ROPE_BASE = 10000.0
EPS = 1e-6
FGATE_BIAS_MEAN = 3.0
RET_LOG_GAMMA = tuple(math.log(1.0 - 2.0 ** (-5 - h)) for h in range(RET_HEADS))
IN_SIZES = (FOX_WIDTH, FOX_WIDTH, FOX_WIDTH, FOX_HEADS, RET_WIDTH, RET_WIDTH, RET_WIDTH, RET_WIDTH)
IN_COLS = sum(IN_SIZES)
SPLIT_POINTS = tuple(int(v) for v in np.cumsum(IN_SIZES)[:-1])

kernel_name = "hymba_fox_retnet_hybrid"


def rmsnorm(x, g):
    x32 = x.astype(jnp.float32)
    y = x32 * lax.rsqrt(jnp.mean(x32 * x32, axis=-1, keepdims=True) + EPS)
    return (y * g.astype(jnp.float32)).astype(x.dtype)


def rotate(x, cos, sin):
    half = x.shape[-1] // 2
    x1, x2 = x[..., :half], x[..., half:]
    c = cos[None, :, None, :].astype(x.dtype)
    s = sin[None, :, None, :].astype(x.dtype)
    return jnp.concatenate([x1 * c - x2 * s, x1 * s + x2 * c], axis=-1)


def fox_attention(q, k, v, logf):
    B, L, H, Dh = q.shape
    scale = Dh ** -0.5
    c = jnp.cumsum(logf, axis=1).transpose(0, 2, 1)
    qh = q.transpose(0, 2, 1, 3)
    kh = k.transpose(0, 2, 1, 3)
    vh = v.transpose(0, 2, 1, 3)
    pos = jnp.arange(L)

    def attend(q_blk, c_q, q_pos, k_, v_, c_k, k_pos):
        s = jnp.einsum('bhqd,bhkd->bhqk', q_blk, k_).astype(jnp.float32) * scale
        s = s + c_q[..., :, None] - c_k[..., None, :]
        s = jnp.where(k_pos[None, :] <= q_pos[:, None], s, -jnp.inf)
        p = jax.nn.softmax(s, axis=-1)
        return jnp.einsum('bhqk,bhkd->bhqd', p.astype(v_.dtype), v_)

    meta_out = attend(qh[:, :, :N_META], c[:, :, :N_META], pos[:N_META],
                      kh[:, :, :N_META], vh[:, :, :N_META], c[:, :, :N_META], pos[:N_META])
    n_blk = (L - N_META) // BLOCK_Q
    q_real = qh[:, :, N_META:].reshape(B, H, n_blk, BLOCK_Q, Dh).transpose(2, 0, 1, 3, 4)
    c_real = c[:, :, N_META:].reshape(B, H, n_blk, BLOCK_Q).transpose(2, 0, 1, 3)
    pos_real = pos[N_META:].reshape(n_blk, BLOCK_Q)
    real_out = lax.map(lambda a: attend(a[0], a[1], a[2], kh, vh, c, pos),
                       (q_real, c_real, pos_real))
    real_out = real_out.transpose(1, 2, 0, 3, 4).reshape(B, H, L - N_META, Dh)
    out = jnp.concatenate([meta_out, real_out], axis=2)
    return out.transpose(0, 2, 1, 3)


def retention_chunkwise(q, k, v):
    B, L, H, Dh = q.shape
    log_g = jnp.array(RET_LOG_GAMMA, dtype=jnp.float32)

    def intra(qc, kc, vc, n):
        idx = jnp.arange(n)
        diff = idx[:, None] - idx[None, :]
        dec = jnp.where(diff >= 0,
                        jnp.exp(jnp.maximum(diff, 0)[None].astype(jnp.float32) * log_g[:, None, None]),
                        0.0)
        s = jnp.einsum('bnhd,bmhd->bhnm', qc, kc).astype(jnp.float32) * dec
        return jnp.einsum('bhnm,bmhd->bnhd', s, vc.astype(jnp.float32))

    qm, km, vm = q[:, :N_META], k[:, :N_META], v[:, :N_META]
    o_meta = intra(qm, km, vm, N_META)
    m_idx = jnp.arange(N_META, dtype=jnp.float32)
    k_dec_meta = jnp.exp((N_META - 1 - m_idx)[:, None] * log_g[None, :])
    state0 = jnp.einsum('bmhd,bmhe->bhde', km.astype(jnp.float32) * k_dec_meta[None, :, :, None],
                        vm.astype(jnp.float32))

    C = RET_CHUNK
    n_chunks = (L - N_META) // C
    j_idx = jnp.arange(C, dtype=jnp.float32)
    q_dec = jnp.exp((j_idx + 1.0)[:, None] * log_g[None, :])[None, :, :, None]
    k_dec = jnp.exp((C - 1.0 - j_idx)[:, None] * log_g[None, :])[None, :, :, None]
    chunk_dec = jnp.exp(C * log_g)[None, :, None, None]

    def to_chunks(t):
        return t[:, N_META:].reshape(B, n_chunks, C, H, Dh).transpose(1, 0, 2, 3, 4)

    def step(state, xs):
        qc, kc, vc = xs
        o = intra(qc, kc, vc, C) + jnp.einsum('bjhd,bhde->bjhe', qc.astype(jnp.float32) * q_dec, state)
        state = chunk_dec * state + jnp.einsum('bjhd,bjhe->bhde', kc.astype(jnp.float32) * k_dec,
                                               vc.astype(jnp.float32))
        return state, o

    _, o_real = lax.scan(step, state0, (to_chunks(q), to_chunks(k), to_chunks(v)))
    o_real = o_real.transpose(1, 0, 2, 3, 4).reshape(B, L - N_META, H, Dh)
    return jnp.concatenate([o_meta, o_real], axis=1)


def head_groupnorm(o, g):
    mu = jnp.mean(o, axis=-1, keepdims=True)
    var = jnp.mean(jnp.square(o - mu), axis=-1, keepdims=True)
    y = (o - mu) * lax.rsqrt(var + EPS)
    B, L, H, Dh = o.shape
    return y.reshape(B, L, H * Dh) * g.astype(jnp.float32)


def hybrid_layer(h, attn_norm_g, w_in, b_fgate, ret_gn_g, w_out,
                 ffn_norm_g, w_gate, w_up, w_down, cos, sin):
    B, L, _ = h.shape
    xn = rmsnorm(h, attn_norm_g)
    proj = jnp.einsum('bld,dc->blc', xn, w_in)
    fq, fk, fv, flog, rq, rk, rv, rg = jnp.split(proj, SPLIT_POINTS, axis=-1)

    logf = jax.nn.log_sigmoid(flog.astype(jnp.float32) + b_fgate.astype(jnp.float32))
    fshape = (B, L, FOX_HEADS, FOX_HEAD_DIM)
    fox_out = fox_attention(fq.reshape(fshape), fk.reshape(fshape), fv.reshape(fshape), logf)
    fox_out = fox_out.reshape(B, L, FOX_WIDTH)

    rshape = (B, L, RET_HEADS, RET_HEAD_DIM)
    rq_ = rotate(rq.reshape(rshape), cos, sin)
    rk_ = rotate(rk.reshape(rshape), cos, sin) * (RET_HEAD_DIM ** -0.5)
    ret = retention_chunkwise(rq_, rk_, rv.reshape(rshape))
    ret = head_groupnorm(ret, ret_gn_g).astype(h.dtype)
    ret_out = jax.nn.silu(rg) * ret

    mix = jnp.concatenate([fox_out, ret_out], axis=-1)
    h = h + jnp.einsum('blc,cd->bld', mix, w_out)

    hn = rmsnorm(h, ffn_norm_g)
    ff = jax.nn.silu(jnp.einsum('bld,df->blf', hn, w_gate)) * jnp.einsum('bld,df->blf', hn, w_up)
    return h + jnp.einsum('blf,fd->bld', ff, w_down)


def setup_inputs(seed: int = 0) -> dict:
    key = jax.random.key(seed)
    ks = jax.random.split(key, 12)
    f32 = jnp.float32
    x = jax.random.normal(ks[0], (BATCH, SEQ, D_MODEL), f32)
    meta_tokens = jax.random.normal(ks[1], (N_META, D_MODEL), f32)
    attn_norm = 1.0 + 0.02 * jax.random.normal(ks[2], (DEPTH, D_MODEL), f32)
    w_in = jax.random.normal(ks[3], (DEPTH, D_MODEL, IN_COLS), f32) * D_MODEL ** -0.5
    b_fgate = FGATE_BIAS_MEAN + 0.5 * jax.random.normal(ks[4], (DEPTH, FOX_HEADS), f32)
    ret_gn = 1.0 + 0.02 * jax.random.normal(ks[5], (DEPTH, RET_WIDTH), f32)
    w_out = jax.random.normal(ks[6], (DEPTH, MIX_WIDTH, D_MODEL), f32) * MIX_WIDTH ** -0.5
    ffn_norm = 1.0 + 0.02 * jax.random.normal(ks[7], (DEPTH, D_MODEL), f32)
    w_gate = jax.random.normal(ks[8], (DEPTH, D_MODEL, D_FF), f32) * D_MODEL ** -0.5
    w_up = jax.random.normal(ks[9], (DEPTH, D_MODEL, D_FF), f32) * D_MODEL ** -0.5
    w_down = jax.random.normal(ks[10], (DEPTH, D_FF, D_MODEL), f32) * D_FF ** -0.5
    final_norm = 1.0 + 0.02 * jax.random.normal(ks[11], (D_MODEL,), f32)
    return {"x": x, "meta_tokens": meta_tokens, "attn_norm": attn_norm, "w_in": w_in,
            "b_fgate": b_fgate, "ret_gn": ret_gn, "w_out": w_out, "ffn_norm": ffn_norm,
            "w_gate": w_gate, "w_up": w_up, "w_down": w_down, "final_norm": final_norm}


def reference(x, meta_tokens, attn_norm, w_in, b_fgate, ret_gn, w_out, ffn_norm,
              w_gate, w_up, w_down, final_norm):
    B = x.shape[0]
    meta = jnp.broadcast_to(meta_tokens[None].astype(x.dtype), (B, N_META, D_MODEL))
    h = jnp.concatenate([meta, x], axis=1)
    L = h.shape[1]
    inv_freq = ROPE_BASE ** (-jnp.arange(0, RET_HEAD_DIM, 2, dtype=jnp.float32) / RET_HEAD_DIM)
    ang = jnp.arange(L, dtype=jnp.float32)[:, None] * inv_freq[None, :]
    cos, sin = jnp.cos(ang), jnp.sin(ang)
    for i in range(DEPTH):
        h = hybrid_layer(h, attn_norm[i], w_in[i], b_fgate[i], ret_gn[i], w_out[i],
                         ffn_norm[i], w_gate[i], w_up[i], w_down[i], cos, sin)
    h = rmsnorm(h, final_norm)
    return h[:, N_META:]
```

```cpp
#include <hip/hip_runtime.h>
#include <hip/hip_cooperative_groups.h>
#include <cstdio>
#include <cstdint>
namespace cg = cooperative_groups;
namespace pg8 {
#define PG8_LAS __attribute__((address_space(3)))
typedef unsigned short bf16_t;
typedef short bf16x8 __attribute__((ext_vector_type(8)));
typedef float f32x4 __attribute__((ext_vector_type(4)));
typedef unsigned u32x4 __attribute__((ext_vector_type(4)));
constexpr int BM = 256, BK = 64, HALF = 128, HTB = HALF * BK * 2  , STAGE_BYTES = 8 * HTB, NXCD = 8, WGM = 8;

__host__ __device__ __forceinline__ int lds_byte(int r, int c) { const int st = (r >> 4) * 2 + (c >> 5), rr = r & 15, cc = c & 31, ob = rr * 64 + cc * 2; return st * 1024 + (ob ^ (((ob >> 9) & 1) << 5)); }
__host__ __device__ __forceinline__ void stage_rc(int b, int& R, int& C) { const int st = b / 1024, sb = b % 1024, swz = sb ^ (((sb >> 9) & 1) << 5); R = (st >> 1) * 16 + swz / 64; C = (st & 1) * 32 + (swz % 64) / 2; }
__host__ __device__ __forceinline__ int perm32(int rho) { const int n = rho >> 4, i = rho & 15; return 8 * (i >> 2) + 4 * n + (i & 3); }

struct Unit { int pm, pn; };
struct Gemm { const bf16_t* A; const bf16_t* Bt; int M, N, K; };

struct StaticOrder {
    int nM, nN, nwg, G, c;
    __host__ __device__ void init(int M, int N, int G_, int c_) { nM = M / BM; nN = N / BM; nwg = nM * nN; G = G_; c = c_; }
    __host__ __device__ bool next(int i, Unit& u) const {
        const long L = (long)i * G + c; if (L >= nwg) return false;
        int wgid = (int)L; { const int q = nwg / NXCD, r = nwg % NXCD, xcd = wgid % NXCD, off = wgid / NXCD; wgid = (xcd < r ? xcd * (q + 1) : r * (q + 1) + (xcd - r) * q) + off; }
        const int nig = WGM * nN, gid = wgid / nig, fm = gid * WGM, gsz = (nM - fm) < WGM ? (nM - fm) : WGM;
        u.pm = fm + ((wgid % nig) % gsz); u.pn = (wgid % nig) / gsz; return true;
    }
    __device__ __forceinline__ void a_ready(const Unit&) const {}
    __device__ __forceinline__ void done(const Unit&) const {}
};

template <class Epi, class Sched, bool ALIGN_EPI, bool SP2, int KC>
__device__ __forceinline__ void gemm_phase(PG8_LAS unsigned char* lds, const Gemm g, const Sched& S, const Epi& E) {
    int tid_ = threadIdx.x; asm volatile("" : "+v"(tid_));
    const int tid = tid_, wid = __builtin_amdgcn_readfirstlane(tid >> 6), lane = tid & 63, wr = wid >> 2, wc = wid & 3, fr = lane & 15, fq = lane >> 4;
    constexpr int K = KC, nt = K / BK;
    unsigned voffA[2], voffB[2];
#pragma unroll
    for (int i = 0; i < 2; ++i) { int R, C; stage_rc(tid * 16 + i * 8192, R, C); const int Rb = Epi::PERM ? ((R & ~31) + perm32(R & 31)) : R;
        voffA[i] = (unsigned)(R * K + C) * 2u; voffB[i] = (unsigned)(Rb * K + C) * 2u; }
    const size_t kstep = (size_t)(BK * 2);
    const size_t hstep = (size_t)HALF * K * 2;
    const size_t tstep = 2 * hstep;
    const unsigned ldsw = (unsigned)wid * 1024u;
    const int aoff = lds_byte(wr * 64 + fr, fq * 8), boff = lds_byte(wc * 32 + fr, fq * 8);
#define PG8_SA(b, h) (((b) * 2 + (h)) * HTB)
#define PG8_SB(b, h) ((4 + (b) * 2 + (h)) * HTB)
#define PG8_STAGE(bufoff, gbase, voff) do { _Pragma("unroll") for (int _i = 0; _i < 2; ++_i) \
        __builtin_amdgcn_global_load_lds((const unsigned*)((const char*)(gbase) + (voff)[_i]), (PG8_LAS unsigned*)(lds + (bufoff) + ldsw + _i * 8192), 16, 0, 0); } while (0)
#define PG8_LDA(dst, b, h) do { _Pragma("unroll") for (int m = 0; m < 4; ++m) _Pragma("unroll") for (int k = 0; k < 2; ++k) dst[m][k] = *(const PG8_LAS bf16x8*)(lds + PG8_SA(b, h) + aoff + m * 2048 + k * 1024); } while (0)
#define PG8_LDB(dst, b, h) do { _Pragma("unroll") for (int n = 0; n < 2; ++n) _Pragma("unroll") for (int k = 0; k < 2; ++k) dst[n][k] = *(const PG8_LAS bf16x8*)(lds + PG8_SB(b, h) + boff + n * 2048 + k * 1024); } while (0)
#define PG8_MMA(ai, bj, At, Bt) do { __builtin_amdgcn_s_setprio(1); _Pragma("unroll") for (int m = 0; m < 4; ++m) _Pragma("unroll") for (int n = 0; n < 2; ++n) _Pragma("unroll") for (int k = 0; k < 2; ++k) \
        acc[ai][bj][m][n] = __builtin_amdgcn_mfma_f32_16x16x32_bf16(Bt[n][k], At[m][k], acc[ai][bj][m][n], 0, 0, 0); __builtin_amdgcn_s_setprio(0); } while (0)
#define PG8_WAIT_V(n) asm volatile("s_waitcnt vmcnt(" #n ")" ::: "memory")
#define PG8_WAIT_L(n) asm volatile("s_waitcnt lgkmcnt(" #n ")" ::: "memory")
#define PG8_BAR __builtin_amdgcn_s_barrier()
#define PG8_SCHED __builtin_amdgcn_sched_barrier(0)
    Unit cur, nxt; int ui = 0;
    if (!S.next(0, cur)) return;
    f32x4 acc[2][2][4][2];
#pragma unroll
    for (int a = 0; a < 2; ++a)
#pragma unroll
        for (int b = 0; b < 2; ++b)
#pragma unroll
            for (int m = 0; m < 4; ++m)
#pragma unroll
                for (int n = 0; n < 2; ++n) acc[a][b][m][n] = (f32x4){0.f, 0.f, 0.f, 0.f};
    bf16x8 At[4][2], B0[2][2], B1[2][2];
    const char* cA = (const char*)g.A + (size_t)cur.pm * tstep; const char* cB = (const char*)g.Bt + (size_t)cur.pn * tstep;
    S.a_ready(cur);
    if constexpr (SP2) {
        PG8_STAGE(PG8_SB(0, 0), cB, voffB); PG8_STAGE(PG8_SB(0, 1), cB + hstep, voffB); PG8_STAGE(PG8_SA(0, 0), cA, voffA); PG8_STAGE(PG8_SA(0, 1), cA + hstep, voffA);
        if (wr == 1) PG8_BAR;
        PG8_WAIT_V(2); PG8_BAR;
        PG8_STAGE(PG8_SB(1, 0), cB + kstep, voffB); PG8_STAGE(PG8_SA(1, 0), cA + kstep, voffA); PG8_STAGE(PG8_SB(1, 1), cB + hstep + kstep, voffB);
        PG8_WAIT_V(6); PG8_BAR;
    } else {
        PG8_STAGE(PG8_SB(0, 0), cB, voffB); PG8_STAGE(PG8_SA(0, 0), cA, voffA); PG8_STAGE(PG8_SB(0, 1), cB + hstep, voffB); PG8_STAGE(PG8_SA(0, 1), cA + hstep, voffA);
        if (wr == 1) PG8_BAR;
        PG8_WAIT_V(4); PG8_BAR;
        PG8_STAGE(PG8_SB(1, 0), cB + kstep, voffB); PG8_STAGE(PG8_SA(1, 0), cA + kstep, voffA); PG8_STAGE(PG8_SB(1, 1), cB + hstep + kstep, voffB);
        PG8_WAIT_V(6); PG8_BAR;
    }
    for (;;) {
        const bool has_next = S.next(ui + 1, nxt);
        const char* nA = has_next ? (const char*)g.A + (size_t)nxt.pm * tstep : cA; const char* nB = has_next ? (const char*)g.Bt + (size_t)nxt.pn * tstep : cB;
        for (int t = 0; t < nt; t += 2) {
            const bool last = (t == nt - 2);
            const char* a1 = cA + (size_t)(t + 1) * kstep;
            const char* a2 = last ? nA : cA + (size_t)(t + 2) * kstep; const char* b2 = last ? nB : cB + (size_t)(t + 2) * kstep;
            const char* a3 = a2 + kstep; const char* b3 = b2 + kstep;
            if (last && has_next) S.a_ready(nxt);
            if constexpr (SP2) {
            PG8_LDB(B0, 0, 0); PG8_LDB(B1, 0, 1); PG8_SCHED; PG8_LDA(At, 0, 0); PG8_STAGE(PG8_SA(1, 1), a1 + hstep, voffA);
            PG8_WAIT_V(8); PG8_WAIT_L(0); PG8_BAR; PG8_MMA(0, 0, At, B0); PG8_MMA(0, 1, At, B1); PG8_BAR; PG8_SCHED;
            PG8_LDA(At, 0, 1); PG8_STAGE(PG8_SB(0, 0), b2, voffB); PG8_STAGE(PG8_SB(0, 1), b2 + hstep, voffB); PG8_STAGE(PG8_SA(0, 0), a2, voffA);
            PG8_WAIT_V(8); PG8_WAIT_L(0); PG8_BAR; PG8_MMA(1, 0, At, B0); PG8_MMA(1, 1, At, B1); PG8_BAR; PG8_SCHED;
            PG8_LDB(B0, 1, 0); PG8_LDB(B1, 1, 1); PG8_SCHED; PG8_LDA(At, 1, 0); PG8_STAGE(PG8_SA(0, 1), a2 + hstep, voffA);
            PG8_WAIT_V(8); PG8_WAIT_L(0); PG8_BAR; PG8_MMA(0, 0, At, B0); PG8_MMA(0, 1, At, B1); PG8_BAR; PG8_SCHED;
            PG8_LDA(At, 1, 1); PG8_STAGE(PG8_SB(1, 0), b3, voffB); PG8_STAGE(PG8_SB(1, 1), b3 + hstep, voffB); PG8_STAGE(PG8_SA(1, 0), a3, voffA);
            PG8_WAIT_V(8); PG8_WAIT_L(0); PG8_BAR; PG8_MMA(1, 0, At, B0); PG8_MMA(1, 1, At, B1); PG8_BAR; PG8_SCHED;
            } else {
            PG8_LDB(B0, 0, 0); PG8_SCHED; PG8_LDA(At, 0, 0); PG8_STAGE(PG8_SA(1, 1), a1 + hstep, voffA);
            PG8_WAIT_L(8); PG8_BAR; PG8_WAIT_L(0); PG8_MMA(0, 0, At, B0); PG8_BAR; PG8_SCHED;
            PG8_LDB(B1, 0, 1); PG8_STAGE(PG8_SB(0, 0), b2, voffB);
            PG8_BAR; PG8_WAIT_L(0); PG8_MMA(0, 1, At, B1); PG8_BAR;
            PG8_LDA(At, 0, 1); PG8_STAGE(PG8_SA(0, 0), a2, voffA);
            PG8_BAR; PG8_WAIT_L(0); PG8_MMA(1, 0, At, B0); PG8_BAR; PG8_SCHED;
            PG8_STAGE(PG8_SB(0, 1), b2 + hstep, voffB);
            PG8_WAIT_V(6); PG8_BAR; PG8_MMA(1, 1, At, B1); PG8_BAR;
            PG8_LDB(B0, 1, 0); PG8_SCHED; PG8_LDA(At, 1, 0); PG8_STAGE(PG8_SA(0, 1), a2 + hstep, voffA);
            PG8_WAIT_L(8); PG8_BAR; PG8_WAIT_L(0); PG8_MMA(0, 0, At, B0); PG8_BAR; PG8_SCHED;
            PG8_LDB(B1, 1, 1); PG8_STAGE(PG8_SB(1, 0), b3, voffB);
            PG8_BAR; PG8_WAIT_L(0); PG8_MMA(0, 1, At, B1); PG8_BAR;
            PG8_LDA(At, 1, 1); PG8_STAGE(PG8_SA(1, 0), a3, voffA);
            PG8_BAR; PG8_WAIT_L(0); PG8_MMA(1, 0, At, B0); PG8_BAR; PG8_SCHED;
            PG8_STAGE(PG8_SB(1, 1), b3 + hstep, voffB);
            PG8_WAIT_V(6); PG8_BAR; PG8_MMA(1, 1, At, B1); PG8_BAR;
            }
        }
        if constexpr (ALIGN_EPI) { if (wr == 0) PG8_BAR; }
        if constexpr (!Epi::AFTER_DRAIN) { E(acc, cur, wr, wc, fr, fq); S.done(cur); }
        if (!has_next) break;
#pragma unroll
        for (int a = 0; a < 2; ++a)
#pragma unroll
            for (int b = 0; b < 2; ++b)
#pragma unroll
                for (int m = 0; m < 4; ++m)
#pragma unroll
                    for (int n = 0; n < 2; ++n) acc[a][b][m][n] = (f32x4){0.f, 0.f, 0.f, 0.f};
        cur = nxt; cA = nA; cB = nB; ++ui;
        if constexpr (ALIGN_EPI) { if (wr == 1) PG8_BAR; }
    }
    PG8_WAIT_V(0);
    if constexpr (!ALIGN_EPI) { if (wr == 0) PG8_BAR; }
    PG8_BAR;
    if constexpr (Epi::AFTER_DRAIN) { E.fused(acc, cur, wr, wc, fr, fq, lds, wid, lane); S.done(cur); }
#undef PG8_SA
#undef PG8_SB
#undef PG8_STAGE
#undef PG8_LDA
#undef PG8_LDB
#undef PG8_MMA
#undef PG8_WAIT_V
#undef PG8_WAIT_L
#undef PG8_BAR
#undef PG8_SCHED
}
}
#ifndef PG8_SP2
#define PG8_SP2 true
#endif
#ifndef PG8_ALIGN
#define PG8_ALIGN true
#endif
#define LAS __attribute__((address_space(3)))
typedef unsigned short bf16_t;
typedef short bf16x8 __attribute__((ext_vector_type(8)));
typedef short s16x4 __attribute__((ext_vector_type(4)));
typedef float f32x2 __attribute__((ext_vector_type(2)));
typedef float f32x4 __attribute__((ext_vector_type(4)));
typedef float f32x16 __attribute__((ext_vector_type(16)));
typedef unsigned u32x2 __attribute__((ext_vector_type(2)));
typedef unsigned u32x4 __attribute__((ext_vector_type(4)));
typedef __bf16 bf16x2_t __attribute__((ext_vector_type(2)));

constexpr int NB = 16, SEQ = 2048, NMETA = 16, DM = 1024, MR = NB * SEQ, MT = MR + NB * NMETA;
constexpr int PJ = 3584, NPJ = 3616, DFF = 2816, NGU = 2 * DFF;
constexpr int C_FQ = 0, C_FK = 512, C_FV = 1024, C_RQ = 1536, C_RK = 2048, C_RV = 2560, C_RG = 3072;
constexpr float EPS = 1e-6f, LOG2E = 1.4426950408889634f;
constexpr size_t MiB = 1u << 20;
constexpr size_t WS_CTL = 0, CTL_BYTES = 1 * MiB, WS_SSQ = 65536;
constexpr size_t WS_WIN = 1 * MiB, WS_WOUT = 16 * MiB, WS_WGU = 20 * MiB, WS_WD = 42 * MiB, WS_CS = 53 * MiB, WS_LF = 55 * MiB, WS_HMETA = 57 * MiB;
constexpr size_t WS_HB = 58 * MiB, WS_MIX = 123 * MiB, WS_PROJ = 188 * MiB, WS_END = 414 * MiB;
constexpr size_t WIN_SZ = (size_t)NPJ * DM * 2, WOUT_SZ = (size_t)DM * DM * 2, WGU_SZ = (size_t)NGU * DM * 2, WD_SZ = (size_t)DM * DFF * 2;
static_assert(WS_WIN + 2 * WIN_SZ <= WS_WOUT && WS_WOUT + 2 * WOUT_SZ <= WS_WGU && WS_WGU + 2 * WGU_SZ <= WS_WD && WS_WD + 2 * WD_SZ <= WS_CS, "ws map (weights)");
static_assert(WS_CS + (size_t)2064 * 64 * 8 <= WS_LF && WS_LF + (size_t)8 * MT * 4 <= WS_HMETA && WS_HB + (size_t)MT * DM * 2 <= WS_MIX && WS_MIX + (size_t)MT * DM * 2 <= WS_PROJ && WS_PROJ + (size_t)MT * PJ * 2 <= WS_END, "ws map");
static_assert(WS_SSQ + 5 * (size_t)MT * 4 <= CTL_BYTES, "ssq inside the memset region");
constexpr int LDS_BYTES = 147456, LDS_XCH = 131072;
constexpr size_t WS_XBUF = WS_HMETA + 512 * 1024;
constexpr int CW_CNT = 204800;

__device__ __forceinline__ unsigned pk2(float lo, float hi) { f32x2 v = {lo, hi}; bf16x2_t b = __builtin_convertvector(v, bf16x2_t); return __builtin_bit_cast(unsigned, b); }
__device__ __forceinline__ float bflo(unsigned u) { return __uint_as_float(u << 16); }
__device__ __forceinline__ float bfhi(unsigned u) { return __uint_as_float(u & 0xffff0000u); }
__device__ __forceinline__ float bf1(short s) { return __uint_as_float(((unsigned)(unsigned short)s) << 16); }
__device__ __forceinline__ bf16x8 pack8(float a, float b, float c, float d, float e, float f, float g, float h) { u32x4 p; p.x = pk2(a, b); p.y = pk2(c, d); p.z = pk2(e, f); p.w = pk2(g, h); return __builtin_bit_cast(bf16x8, p); }
__device__ __forceinline__ int crow(int r, int hi) { return (r & 3) + 8 * (r >> 2) + 4 * hi; }
__device__ __forceinline__ float ex2(float x) { return __builtin_amdgcn_exp2f(x); }
__device__ __forceinline__ float silu_f(float g) { return g * __builtin_amdgcn_rcpf(1.f + ex2(-g * LOG2E)); }
__device__ __forceinline__ float wave_sum(float v) {
#pragma unroll
    for (int o = 1; o < 64; o <<= 1) v += __shfl_xor(v, o);
    return v;
}
#define MFMA32(a, b, c) __builtin_amdgcn_mfma_f32_32x32x16_bf16((a), (b), (c), 0, 0, 0)

struct EpiInProj {
    static constexpr bool PERM = true, AFTER_DRAIN = false;
    bf16_t* proj; const float* ssq;
    __device__ __forceinline__ void operator()(const f32x4 (&acc)[2][2][4][2], const pg8::Unit& u, int wr, int wc, int fr, int fq) const {
        const int row0 = u.pm * 256 + wr * 64 + fr;
        {
            const int col0 = u.pn * 256 + wc * 32 + 8 * fq;
#pragma unroll
            for (int ai = 0; ai < 2; ++ai)
#pragma unroll
                for (int m = 0; m < 4; ++m) {
                    const int row = row0 + ai * 128 + m * 16;
                    const float rs = rsqrtf(ssq[row] * (1.f / DM) + EPS);
                    bf16_t* rp = proj + (size_t)row * PJ + col0;
#pragma unroll
                    for (int bj = 0; bj < 2; ++bj) {
                        const f32x4 v0 = acc[ai][bj][m][0] * rs, v1 = acc[ai][bj][m][1] * rs;
                        u32x4 w; w.x = pk2(v0[0], v0[1]); w.y = pk2(v0[2], v0[3]); w.z = pk2(v1[0], v1[1]); w.w = pk2(v1[2], v1[3]);
                        *(u32x4*)(rp + bj * 128) = w;
                    }
                }
        }
    }
};
struct EpiResid {
    static constexpr bool PERM = false, AFTER_DRAIN = false;
    const float* in_f32; bf16_t* hb; float* ssq;
    __device__ __forceinline__ void operator()(const f32x4 (&acc)[2][2][4][2], const pg8::Unit& u, int wr, int wc, int fr, int fq) const {
        const int col0 = u.pn * 256 + wc * 32 + 4 * fq;
#pragma unroll
        for (int ai = 0; ai < 2; ++ai)
#pragma unroll
            for (int m = 0; m < 4; ++m) {
                const int row = u.pm * 256 + ai * 128 + wr * 64 + m * 16 + fr;
                bf16_t* bp = hb + (size_t)row * DM;
                float ss = 0.f;
#pragma unroll
                for (int bj = 0; bj < 2; ++bj)
#pragma unroll
                    for (int n = 0; n < 2; ++n) {
                        const int c = col0 + bj * 128 + n * 16;
                        f32x4 hv;
                        if (in_f32) hv = *(const f32x4*)(in_f32 + (size_t)row * DM + c);
                        else { const u32x2 hw = *(const u32x2*)(bp + c); hv = (f32x4){bflo(hw.x), bfhi(hw.x), bflo(hw.y), bfhi(hw.y)}; }
                        const f32x4 o = hv + acc[ai][bj][m][n];
                        u32x2 w; w.x = pk2(o[0], o[1]); w.y = pk2(o[2], o[3]);
                        *(u32x2*)(bp + c) = w;
                        ss += (o[0] * o[0] + o[1] * o[1]) + (o[2] * o[2] + o[3] * o[3]);
                    }
                ss += __shfl_xor(ss, 16); ss += __shfl_xor(ss, 32);
                if (fq == 0) (void)__hip_atomic_fetch_add(ssq + row, ss, __ATOMIC_RELAXED, __HIP_MEMORY_SCOPE_AGENT);
                if (m & 1) asm volatile("" ::: "memory");
            }
    }
};
struct EpiResidNorm {
    static constexpr bool PERM = false, AFTER_DRAIN = false;
    const bf16_t* in_hb; float* out_real; const float* gain; float* xbuf; unsigned* cnt; LAS unsigned char* sc;
    __device__ __forceinline__ void operator()(f32x4 (&acc)[2][2][4][2], const pg8::Unit& u, int wr, int wc, int fr, int fq) const {
        LAS float* P = (LAS float*)sc;
        LAS float* S = (LAS float*)(sc + 4096);
        const int lane = threadIdx.x & 63, wid = wr * 4 + wc;
        const int col0 = u.pn * 256 + wc * 32 + 4 * fq;
#pragma unroll
        for (int ai = 0; ai < 2; ++ai)
#pragma unroll
            for (int m = 0; m < 4; ++m) {
                const int rl = ai * 128 + wr * 64 + m * 16 + fr;
                const bf16_t* ip = in_hb + (size_t)(u.pm * 256 + rl) * DM;
                float ss = 0.f;
#pragma unroll
                for (int bj = 0; bj < 2; ++bj)
#pragma unroll
                    for (int n = 0; n < 2; ++n) {
                        const u32x2 hw = *(const u32x2*)(ip + col0 + bj * 128 + n * 16);
                        const f32x4 o = (f32x4){bflo(hw.x), bfhi(hw.x), bflo(hw.y), bfhi(hw.y)} + acc[ai][bj][m][n];
                        acc[ai][bj][m][n] = o;
                        ss += (o[0] * o[0] + o[1] * o[1]) + (o[2] * o[2] + o[3] * o[3]);
                    }
                ss += __shfl_xor(ss, 16); ss += __shfl_xor(ss, 32);
                if (fq == 0) P[rl * 4 + wc] = ss;
                if (m & 1) asm volatile("" ::: "memory");
            }
        asm volatile("s_waitcnt lgkmcnt(0)" ::: "memory"); __builtin_amdgcn_s_barrier(); asm volatile("" ::: "memory");
        const int rowp = wid * 32 + (lane & 31);
        if (lane < 32) {
            const float t = (P[rowp * 4] + P[rowp * 4 + 1]) + (P[rowp * 4 + 2] + P[rowp * 4 + 3]);
            __hip_atomic_store(xbuf + (size_t)(u.pm * 256 + rowp) * 4 + u.pn, t, __ATOMIC_RELAXED, __HIP_MEMORY_SCOPE_AGENT);
        }
        asm volatile("s_waitcnt vmcnt(0)" ::: "memory");
        if (lane == 0) (void)__hip_atomic_fetch_add(cnt + 64 * u.pm, 1u, __ATOMIC_RELAXED, __HIP_MEMORY_SCOPE_AGENT);
        if (wid == 0) {
            unsigned spins = 0;
            while ((unsigned)__builtin_amdgcn_readfirstlane(__hip_atomic_load(cnt + 64 * u.pm, __ATOMIC_RELAXED, __HIP_MEMORY_SCOPE_AGENT)) < 32u) { __builtin_amdgcn_s_sleep(2); if (++spins > (1u << 20)) break; }
            __builtin_amdgcn_fence(__ATOMIC_ACQUIRE, "agent");
        }
        asm volatile("s_waitcnt vmcnt(0) lgkmcnt(0)" ::: "memory"); __builtin_amdgcn_s_barrier(); asm volatile("" ::: "memory");
        if (lane < 32) {
            const float* slot = xbuf + (size_t)(u.pm * 256 + rowp) * 4;
            const float t = (__hip_atomic_load(slot, __ATOMIC_RELAXED, __HIP_MEMORY_SCOPE_AGENT) + __hip_atomic_load(slot + 1, __ATOMIC_RELAXED, __HIP_MEMORY_SCOPE_AGENT))
                          + (__hip_atomic_load(slot + 2, __ATOMIC_RELAXED, __HIP_MEMORY_SCOPE_AGENT) + __hip_atomic_load(slot + 3, __ATOMIC_RELAXED, __HIP_MEMORY_SCOPE_AGENT));
            S[rowp] = rsqrtf(t * (1.f / DM) + EPS);
        }
        asm volatile("s_waitcnt vmcnt(0) lgkmcnt(0)" ::: "memory"); __builtin_amdgcn_s_barrier(); asm volatile("" ::: "memory");
#pragma unroll
        for (int ai = 0; ai < 2; ++ai)
#pragma unroll
            for (int m = 0; m < 4; ++m) {
                const int rl = ai * 128 + wr * 64 + m * 16 + fr;
                const float rs = S[rl];
                float* op = out_real + (size_t)(u.pm * 256 + rl) * DM;
#pragma unroll
                for (int bj = 0; bj < 2; ++bj)
#pragma unroll
                    for (int n = 0; n < 2; ++n) {
                        const int c = col0 + bj * 128 + n * 16;
                        *(f32x4*)(op + c) = acc[ai][bj][m][n] * rs * *(const f32x4*)(gain + c);
                    }
            }
        asm volatile("s_waitcnt lgkmcnt(0)" ::: "memory"); __builtin_amdgcn_s_barrier(); asm volatile("" ::: "memory");
    }
};
struct EpiSwiGLU {
    static constexpr bool PERM = true, AFTER_DRAIN = false;
    bf16_t* ff; const float* ssq;
    __device__ __forceinline__ void operator()(const f32x4 (&acc)[2][2][4][2], const pg8::Unit& u, int wr, int wc, int fr, int fq) const {
        const int row0 = u.pm * 256 + wr * 64 + fr, col0 = u.pn * 128 + wc * 32 + 8 * fq;
#pragma unroll
        for (int ai = 0; ai < 2; ++ai)
#pragma unroll
            for (int m = 0; m < 4; ++m) {
                const int row = row0 + ai * 128 + m * 16;
                const float rs = rsqrtf(ssq[row] * (1.f / DM) + EPS);
                float f[8];
#pragma unroll
                for (int n = 0; n < 2; ++n)
#pragma unroll
                    for (int e = 0; e < 4; ++e) { const float g = acc[ai][0][m][n][e] * rs, up = acc[ai][1][m][n][e] * rs; f[4 * n + e] = silu_f(g) * up; }
                u32x4 w; w.x = pk2(f[0], f[1]); w.y = pk2(f[2], f[3]); w.z = pk2(f[4], f[5]); w.w = pk2(f[6], f[7]);
                *(u32x4*)(ff + (size_t)row * DFF + col0) = w;
            }
    }
};

#define MFMA16(a, b, c) __builtin_amdgcn_mfma_f32_16x16x32_bf16((a), (b), (c), 0, 0, 0)
template <int K> __device__ __forceinline__ f32x4 mini16(const bf16_t* A, int lda, const bf16_t* Bn, int lane) {
    const bf16_t* ap = A + (size_t)(lane & 15) * lda + 8 * (lane >> 4);
    const bf16_t* bp = Bn + (size_t)(lane & 15) * K + 8 * (lane >> 4);
    float z_ = 0.f; asm volatile("" : "+v"(z_));
    f32x4 acc = {z_, z_, z_, z_}, acc2 = {z_, z_, z_, z_};
#pragma unroll 8
    for (int s = 0; s < K / 32; s += 2) {
        const bf16x8 a = *(const bf16x8*)(ap + 32 * s), b = *(const bf16x8*)(bp + 32 * s), a2 = *(const bf16x8*)(ap + 32 * s + 32), b2 = *(const bf16x8*)(bp + 32 * s + 32);
        acc = MFMA16(b, a, acc); acc2 = MFMA16(b2, a2, acc2);
    }
    return acc + acc2;
}
__device__ __forceinline__ float logsig2(float z) { return (fminf(z, 0.f) - log1pf(__expf(-fabsf(z)))) * LOG2E; }
__device__ __forceinline__ void mini_resid(const f32x4 acc, const float* in16, float* hmeta, bf16_t* hb, float* ssq, int t, int lane) {
    const int j = lane & 15, col = 16 * t + 4 * (lane >> 4);
    const f32x4 o = *(const f32x4*)(in16 + (size_t)j * DM + col) + acc;
    *(f32x4*)(hmeta + (size_t)j * DM + col) = o;
    u32x2 w; w.x = pk2(o[0], o[1]); w.y = pk2(o[2], o[3]);
    *(u32x2*)(hb + (size_t)(MR + j) * DM + col) = w;
    float ss = (o[0] * o[0] + o[1] * o[1]) + (o[2] * o[2] + o[3] * o[3]);
    ss += __shfl_xor(ss, 16); ss += __shfl_xor(ss, 32);
    if (lane < 16) (void)__hip_atomic_fetch_add(ssq + MR + j, ss, __ATOMIC_RELAXED, __HIP_MEMORY_SCOPE_AGENT);
}
__device__ __forceinline__ void transpose_item(const float* W, int K, int Nsrc, const float* gain, bf16_t* WT, LAS float* scr, int k0, int n0, int srccol4, int lane, float colscale = 1.f) {
    const int kr = lane >> 3, nq = lane & 7;
#pragma unroll
    for (int i = 0; i < 8; ++i) {
        const int kk = 8 * i + kr;
        f32x4 v = {0.f, 0.f, 0.f, 0.f};
        if (srccol4 >= 0) { v = *(const f32x4*)(W + (size_t)(k0 + kk) * Nsrc + srccol4); if (gain) v = v * (gain[k0 + kk] * colscale); }
        LAS float* d = scr + kk * 33 + 4 * nq;
        d[0] = v[0]; d[1] = v[1]; d[2] = v[2]; d[3] = v[3];
    }
    asm volatile("s_waitcnt lgkmcnt(0)" ::: "memory");
    const int c = lane & 7;
#pragma unroll
    for (int j = 0; j < 4; ++j) {
        const int n = (lane >> 3) + 8 * j; const LAS float* s = scr + (8 * c) * 33 + n;
        u32x4 o; o.x = pk2(s[0 * 33], s[1 * 33]); o.y = pk2(s[2 * 33], s[3 * 33]); o.z = pk2(s[4 * 33], s[5 * 33]); o.w = pk2(s[6 * 33], s[7 * 33]);
        *(u32x4*)(WT + (size_t)(n0 + n) * K + k0 + 8 * c) = o;
    }
    asm volatile("s_waitcnt lgkmcnt(0)" ::: "memory");
}

struct KArgs {
    const float* x; const float* meta; const float* attn_norm; const float* w_in; const float* b_fgate; const float* ret_gn; const float* w_out;
    const float* ffn_norm; const float* w_gate; const float* w_up; const float* w_down; const float* final_norm;
    float* out; unsigned char* ws;
};

typedef const __attribute__((address_space(4))) KArgs* KAp;
__device__ __forceinline__ void prologue(KAp ap, LAS unsigned char* lds, int gw, int NGW, int wave, int lane) {
    KArgs a; a.x = ap->x; a.meta = ap->meta; a.attn_norm = ap->attn_norm; a.w_in = ap->w_in; a.w_out = ap->w_out; a.ffn_norm = ap->ffn_norm; a.w_gate = ap->w_gate; a.w_up = ap->w_up; a.w_down = ap->w_down; a.ws = ap->ws;
    LAS float* scr = (LAS float*)(lds + wave * 16384);
    constexpr int I_IN = 16 * (NPJ / 32), I_OUT = 16 * (DM / 32), I_GU = 16 * (NGU / 32), I_D = (DFF / 64) * (DM / 32), I_L = I_IN + I_OUT + I_GU + I_D;
    for (int it = gw; it < 2 * I_L; it += NGW) {
        const int l = it / I_L; int r = it % I_L;
        if (r < I_IN) {
            const int nblk = NPJ / 32, kb = r / nblk, nb = r % nblk, n0 = 32 * nb, np = n0 + 4 * (lane & 7);
            int sc;
            if (np < 1536) sc = np; else if (np < 3584) sc = np + 8; else if (np < 3592) sc = np - 2048; else sc = -1;
            transpose_item(a.w_in + (size_t)l * DM * 3592, DM, 3592, a.attn_norm + l * DM, (bf16_t*)(a.ws + WS_WIN + l * WIN_SZ), scr, 64 * kb, n0, sc, lane, n0 < 512 ? 0.125f * LOG2E : 1.f);
            continue;
        }
        r -= I_IN;
        if (r < I_OUT) {
            const int nblk = DM / 32, kb = r / nblk, nb = r % nblk, n0 = 32 * nb;
            transpose_item(a.w_out + (size_t)l * DM * DM, DM, DM, nullptr, (bf16_t*)(a.ws + WS_WOUT + l * WOUT_SZ), scr, 64 * kb, n0, n0 + 4 * (lane & 7), lane);
            continue;
        }
        r -= I_OUT;
        if (r < I_GU) {
            const int nblk = NGU / 32, kb = r / nblk, nb = r % nblk, n0 = 32 * nb;
            const int pn = n0 >> 8, bj = (n0 >> 7) & 1, c = (n0 & 127) + 4 * (lane & 7);
            const float* src = (bj ? a.w_up : a.w_gate) + (size_t)l * DM * DFF;
            transpose_item(src, DM, DFF, a.ffn_norm + l * DM, (bf16_t*)(a.ws + WS_WGU + l * WGU_SZ), scr, 64 * kb, n0, 128 * pn + c, lane);
            continue;
        }
        r -= I_GU;
        {
            const int nblk = DM / 32, kb = r / nblk, nb = r % nblk, n0 = 32 * nb;
            transpose_item(a.w_down + (size_t)l * DFF * DM, DFF, DM, nullptr, (bf16_t*)(a.ws + WS_WD + l * WD_SZ), scr, 64 * kb, n0, n0 + 4 * (lane & 7), lane);
        }
    }
    {
        f32x2* cs = (f32x2*)(a.ws + WS_CS);
        for (int i = gw * 64 + lane; i < 2064 * 64; i += NGW * 64) {
            const int t = i >> 6, f = i & 63;
            const float invf = powf(10000.0f, -(float)(2 * f) / 128.0f);
            const float ang = (float)t * invf;
            const double ad = (double)ang;
            const double kq = rint(ad * 0.63661977236758134308);
            double rr = fma(-kq, 1.57079632679489655800e+00, ad); rr = fma(-kq, 6.12323399573676603587e-17, rr);
            const double r2 = rr * rr;
            double sp = -1.0 / 39916800.0; sp = sp * r2 + 1.0 / 362880.0; sp = sp * r2 - 1.0 / 5040.0; sp = sp * r2 + 1.0 / 120.0; sp = sp * r2 - 1.0 / 6.0; sp = sp * r2 + 1.0; sp *= rr;
            double cp = 1.0 / 479001600.0; cp = cp * r2 - 1.0 / 3628800.0; cp = cp * r2 + 1.0 / 40320.0; cp = cp * r2 - 1.0 / 720.0; cp = cp * r2 + 1.0 / 24.0; cp = cp * r2 - 0.5; cp = cp * r2 + 1.0;
            const int q = ((int)kq) & 3;
            const double sv = (q == 0) ? sp : (q == 1) ? cp : (q == 2) ? -sp : -cp;
            const double cv = (q == 0) ? cp : (q == 1) ? -sp : (q == 2) ? -cp : sp;
            cs[i] = (f32x2){(float)cv, (float)sv};
        }
    }
    {
        bf16_t* hb = (bf16_t*)(a.ws + WS_HB); float* ssq = (float*)(a.ws + WS_SSQ);
        for (int row = gw; row < MR + 16; row += NGW) {
            const float* src = row < MR ? a.x + (size_t)row * DM : a.meta + (size_t)(row - MR) * DM;
            f32x4 v[4]; float s = 0.f;
#pragma unroll
            for (int j = 0; j < 4; ++j) { v[j] = *(const f32x4*)(src + 4 * (lane + 64 * j)); s += (v[j][0] * v[j][0] + v[j][1] * v[j][1]) + (v[j][2] * v[j][2] + v[j][3] * v[j][3]); }
            s = wave_sum(s);
#pragma unroll
            for (int j = 0; j < 4; ++j) { u32x2 w; w.x = pk2(v[j][0], v[j][1]); w.y = pk2(v[j][2], v[j][3]); *(u32x2*)(hb + (size_t)row * DM + 4 * (lane + 64 * j)) = w; }
            if (lane == 0) ssq[row] = s;
        }
    }
}

typedef short v4i16_t __attribute__((ext_vector_type(4)));
__device__ __forceinline__ s16x4 vtr(const LAS bf16_t* p) { return __builtin_bit_cast(s16x4, __builtin_amdgcn_ds_read_tr16_b64_v4i16((LAS v4i16_t*)p)); }
__device__ __forceinline__ u32x4 zero4u() { unsigned z = 0u; asm volatile("" : "+v"(z)); return (u32x4){z, z, z, z}; }
__device__ __forceinline__ float max3f(float a, float b, float c) { float r; asm("v_max3_f32 %0, %1, %2, %3" : "=v"(r) : "v"(a), "v"(b), "v"(c)); return r; }
constexpr int FOX_KS = 0, FOX_VS = 36864, FOX_C2 = 73728, FOX_WT = 82432, FOX_STG = 18432;
__device__ __forceinline__ void fox_unit(LAS unsigned char* lds, const bf16_t* __restrict__ proj, const float* __restrict__ lf, bf16_t* __restrict__ mix, int b, int h, int qb) {
    int tid_ = threadIdx.x; asm volatile("" : "+v"(tid_));
    const int tid = tid_, lane = tid & 63, w = __builtin_amdgcn_readfirstlane(tid >> 6), ql = lane & 31, hi = lane >> 5;
    LAS float* C2 = (LAS float*)(lds + FOX_C2); LAS float* WT = (LAS float*)(lds + FOX_WT);
    const bool meta = qb < 0;
    const int NS = meta ? 0 : 2 * (qb + 1);
    const int sq = meta ? 0 : 256 * qb + 32 * w + ql;
    const int wq0 = 256 * qb + 32 * w;
    const size_t qrow = meta ? (size_t)(MR + (ql & 15)) : (size_t)b * SEQ + sq;
    bf16x8 Q[4];
#pragma unroll
    for (int d0 = 0; d0 < 4; ++d0) Q[d0] = *(const bf16x8*)(proj + qrow * PJ + C_FQ + h * 64 + 16 * d0 + 8 * hi);
    const int qpos_meta = meta ? (32 * w + ql) : 100000;
    const int lkv = tid >> 3, lch = tid & 7;
    const int trq = (lane & 15) >> 2, trp = lane & 3, trb = (lane >> 4) & 1;
    const u32x4 zz = zero4u();
    u32x4 kreg0 = zz, kreg1 = zz, vreg0 = zz, vreg1 = zz;
#define FOX_GLOAD(st_) do { const int s__ = (st_); \
        if (s__ == 0) { if (lkv < 16) { const bf16_t* r__ = proj + (size_t)(MR + lkv) * PJ + h * 64 + 8 * lch; kreg0 = *(const u32x4*)(r__ + C_FK); vreg0 = *(const u32x4*)(r__ + C_FV); } else { kreg0 = zz; vreg0 = zz; } } \
        else { const bf16_t* r__ = proj + ((size_t)b * SEQ + 128 * (s__ - 1) + lkv) * PJ + h * 64 + 8 * lch; \
               kreg0 = *(const u32x4*)(r__ + C_FK); vreg0 = *(const u32x4*)(r__ + C_FV); kreg1 = *(const u32x4*)(r__ + (size_t)64 * PJ + C_FK); vreg1 = *(const u32x4*)(r__ + (size_t)64 * PJ + C_FV); } } while (0)
#define FOX_WRITE(st_) do { const int s__ = (st_); LAS bf16_t* kd__ = (LAS bf16_t*)(lds + FOX_KS + (s__ & 1) * FOX_STG) + lkv * 72 + 8 * lch; LAS bf16_t* vd__ = (LAS bf16_t*)(lds + FOX_VS + (s__ & 1) * FOX_STG) + lkv * 72 + 8 * lch; \
        *(LAS u32x4*)kd__ = kreg0; *(LAS u32x4*)vd__ = vreg0; if (s__ > 0) { *(LAS u32x4*)(kd__ + 64 * 72) = kreg1; *(LAS u32x4*)(vd__ + 64 * 72) = vreg1; } } while (0)
    FOX_GLOAD(NS);
    {
        const float* lfr = lf + (size_t)h * MT + (size_t)b * SEQ;
        const float* lfm = lf + (size_t)h * MT + MR;
        const f32x4 v = *(const f32x4*)(lfr + 4 * tid);
        const f32x4 m0 = *(const f32x4*)(lfm), m1 = *(const f32x4*)(lfm + 4), m2 = *(const f32x4*)(lfm + 8), m3 = *(const f32x4*)(lfm + 12);
        const float mv[16] = {m0[0], m0[1], m0[2], m0[3], m1[0], m1[1], m1[2], m1[3], m2[0], m2[1], m2[2], m2[3], m3[0], m3[1], m3[2], m3[3]};
        float mt = 0.f, mpre = 0.f;
#pragma unroll
        for (int j = 0; j < 16; ++j) { mt += mv[j]; if (j <= tid) mpre += mv[j]; }
        if (tid < 16) C2[tid] = -mpre;
        const float p0 = v[0], p1 = p0 + v[1], p2 = p1 + v[2], p3 = p2 + v[3];
        float xs = p3;
#pragma unroll
        for (int o = 1; o < 64; o <<= 1) { const float y = __shfl_up(xs, o); if (lane >= o) xs += y; }
        if (lane == 63) WT[w] = xs;
        __syncthreads();
        float off = mt;
        for (int i = 0; i < w; ++i) off += WT[i];
        off += xs - p3;
        *(LAS f32x4*)(C2 + 16 + 4 * tid) = (f32x4){-(off + p0), -(off + p1), -(off + p2), -(off + p3)};
    }
    f32x16 O0, O1;
#pragma unroll
    for (int r = 0; r < 16; ++r) { O0[r] = 0.f; O1[r] = 0.f; }
    float mrun = -INFINITY;
    f32x16 L;
#pragma unroll
    for (int r = 0; r < 16; ++r) L[r] = 0.f;
    const bf16x8 ones8 = {(short)0x3F80, (short)0x3F80, (short)0x3F80, (short)0x3F80, (short)0x3F80, (short)0x3F80, (short)0x3F80, (short)0x3F80};
    FOX_WRITE(NS);
    __syncthreads();
    if (NS >= 1) FOX_GLOAD(NS - 1);
#define FOX_QK(x0, x1, KB, rbase, pb) do { \
        _Pragma("unroll") for (int g = 0; g < 4; ++g) { \
            const f32x4 c0_ = *(const LAS f32x4*)(C2 + (pb) + 8 * g + 4 * hi), c1_ = *(const LAS f32x4*)(C2 + (pb) + 32 + 8 * g + 4 * hi); \
            _Pragma("unroll") for (int i = 0; i < 4; ++i) { x0[4 * g + i] = c0_[i]; x1[4 * g + i] = c1_[i]; } } \
        _Pragma("unroll") for (int d0 = 0; d0 < 4; ++d0) { \
            const bf16x8 kf0_ = *(const LAS bf16x8*)((KB) + ((rbase) + ql) * 72 + 16 * d0 + 8 * hi), kf1_ = *(const LAS bf16x8*)((KB) + ((rbase) + 32 + ql) * 72 + 16 * d0 + 8 * hi); \
            x0 = MFMA32(kf0_, Q[d0], x0); x1 = MFMA32(kf1_, Q[d0], x1); } \
        asm volatile("s_nop 15\n\ts_nop 7" : "+v"(x0), "+v"(x1));   } while (0)
#define FOX_PV(x0, x1, VB, rbase) do { \
        bf16x8 Pk[4]; \
        Pk[0] = pack8(x0[0], x0[1], x0[2], x0[3], x0[4], x0[5], x0[6], x0[7]); Pk[1] = pack8(x0[8], x0[9], x0[10], x0[11], x0[12], x0[13], x0[14], x0[15]); \
        Pk[2] = pack8(x1[0], x1[1], x1[2], x1[3], x1[4], x1[5], x1[6], x1[7]); Pk[3] = pack8(x1[8], x1[9], x1[10], x1[11], x1[12], x1[13], x1[14], x1[15]); \
        _Pragma("unroll") for (int s = 0; s < 4; ++s) { \
            const LAS bf16_t* vb = (VB) + ((rbase) + 16 * s + 4 * hi + trq) * 72 + 16 * trb + 4 * trp; \
            const s16x4 l0_ = vtr(vb), h0_ = vtr(vb + 8 * 72), l1_ = vtr(vb + 32), h1_ = vtr(vb + 8 * 72 + 32); \
            const bf16x8 va0_ = __builtin_shufflevector(l0_, h0_, 0, 1, 2, 3, 4, 5, 6, 7), va1_ = __builtin_shufflevector(l1_, h1_, 0, 1, 2, 3, 4, 5, 6, 7); \
            O0 = MFMA32(va0_, Pk[s], O0); O1 = MFMA32(va1_, Pk[s], O1); L = MFMA32(ones8, Pk[s], L); } } while (0)
    for (int st = NS; st >= 0; --st) {
        if (w >= 4) __builtin_amdgcn_s_sleep(8);
        const LAS bf16_t* KB = (const LAS bf16_t*)(lds + FOX_KS + (st & 1) * FOX_STG); const LAS bf16_t* VB = (const LAS bf16_t*)(lds + FOX_VS + (st & 1) * FOX_STG);
        const int jA = 2 * (st - 1);
        const bool actA = (st == 0) || (64 * jA <= wq0 + 31), actB = (st > 0) && (64 * (jA + 1) <= wq0 + 31);
        if (actA) {
            f32x16 a0, a1, b0, b1;
            const int pbA = (st == 0) ? 0 : 16 + 64 * jA;
            FOX_QK(a0, a1, KB, 0, pbA);
            if (st == 0) {
                const int thr = (qpos_meta < 15 ? qpos_meta : 15) - 4 * hi;
#pragma unroll
                for (int r = 0; r < 16; ++r) { if ((r & 3) + 8 * (r >> 2) > thr) a0[r] = -INFINITY; a1[r] = -INFINITY; }
            } else if (64 * jA + 63 > wq0) {
                const int thr = sq - 64 * jA - 4 * hi;
#pragma unroll
                for (int r = 0; r < 16; ++r) { if ((r & 3) + 8 * (r >> 2) > thr) a0[r] = -INFINITY; if (32 + (r & 3) + 8 * (r >> 2) > thr) a1[r] = -INFINITY; }
            }
            float mx = max3f(a0[0], a1[0], a0[1]), mx2 = max3f(a1[1], a0[2], a1[2]);
#pragma unroll
            for (int r = 3; r < 15; r += 2) { mx = max3f(mx, a0[r], a1[r]); mx2 = max3f(mx2, a0[r + 1], a1[r + 1]); }
            mx = max3f(mx, a0[15], a1[15]);
            if (actB) {
                FOX_QK(b0, b1, KB, 64, pbA + 64);
                if (64 * jA + 127 > wq0) {
                    const int thr = sq - 64 * jA - 64 - 4 * hi;
#pragma unroll
                    for (int r = 0; r < 16; ++r) { if ((r & 3) + 8 * (r >> 2) > thr) b0[r] = -INFINITY; if (32 + (r & 3) + 8 * (r >> 2) > thr) b1[r] = -INFINITY; }
                }
#pragma unroll
                for (int r = 0; r < 16; r += 2) { mx = max3f(mx, b0[r], b1[r]); mx2 = max3f(mx2, b0[r + 1], b1[r + 1]); }
            }
            mx = max3f(mx, mx2, mx2);
            if (!__all(mx <= mrun - 40.0f)) {
            mx = fmaxf(mx, __shfl_xor(mx, 32));
            const float mn = fmaxf(mrun, mx);
            const float alpha = ex2(mrun - mn);
            mrun = mn;
#pragma unroll
            for (int r = 0; r < 16; ++r) { a0[r] = ex2(a0[r] - mn); a1[r] = ex2(a1[r] - mn); }
            if (actB) {
#pragma unroll
                for (int r = 0; r < 16; ++r) { b0[r] = ex2(b0[r] - mn); b1[r] = ex2(b1[r] - mn); }
            }
            L[0] *= alpha;
            O0 = O0 * alpha; O1 = O1 * alpha;
            FOX_PV(a0, a1, VB, 0);
            if (actB) FOX_PV(b0, b1, VB, 64);
            }
        }
        if (st >= 1) FOX_WRITE(st - 1);
        __syncthreads();
        if (st >= 2) FOX_GLOAD(st - 2);
    }
#undef FOX_GLOAD
#undef FOX_WRITE
#undef FOX_QK
#undef FOX_PV
    const float inv = 1.0f / L[0];
    if (!meta || (w == 0 && ql < 16)) {
        bf16_t* op = mix + qrow * DM + h * 64;
#pragma unroll
        for (int g = 0; g < 4; ++g) {
            const int d = 8 * g + 4 * hi;
            u32x2 w0, w1;
            w0.x = pk2(O0[4 * g] * inv, O0[4 * g + 1] * inv); w0.y = pk2(O0[4 * g + 2] * inv, O0[4 * g + 3] * inv);
            w1.x = pk2(O1[4 * g] * inv, O1[4 * g + 1] * inv); w1.y = pk2(O1[4 * g + 2] * inv, O1[4 * g + 3] * inv);
            *(u32x2*)(op + d) = w0; *(u32x2*)(op + 32 + d) = w1;
        }
    }
    __syncthreads();
}

constexpr int RET_KI = 0, RET_QI = 34816, RET_ST = 69632, RET_VI = 104448, RET_RED = 141312, RP = 136, RPV = 144;
__device__ __forceinline__ void ret_unit(LAS unsigned char* lds, const bf16_t* __restrict__ proj, const float* __restrict__ gn, bf16_t* __restrict__ mix, int b, int h, int part2) {
    const int c_end = part2 ? 16 : 8, c_full = part2 ? 8 : -1;
    int tid_ = threadIdx.x; asm volatile("" : "+v"(tid_));
    const int tid = tid_, lane = tid & 63, w = __builtin_amdgcn_readfirstlane(tid >> 6), ql = lane & 31, hi = lane >> 5;
    const int qi = w & 3, eh = w >> 2, eB = w >> 1, dB0 = 2 * (w & 1);
    const int trq = (lane & 15) >> 2, trp = lane & 3, trb = (lane >> 4) & 1;
    LAS bf16_t* KI = (LAS bf16_t*)(lds + RET_KI); LAS bf16_t* QI = (LAS bf16_t*)(lds + RET_QI); LAS bf16_t* ST = (LAS bf16_t*)(lds + RET_ST); LAS bf16_t* VI = (LAS bf16_t*)(lds + RET_VI);
    LAS float* RED = (LAS float*)(lds + RET_RED);
    const float lg = log2f(1.0f - ex2(-(float)(5 + h)));
    constexpr float KSC = 0.08838834764831845f;
    const u32x4 zz = zero4u();
    for (int i = tid; i < 34816 / 16; i += 512) *(LAS u32x4*)(lds + RET_ST + 16 * i) = zz;
    f32x16 SA0, SA1;
#pragma unroll
    for (int r = 0; r < 16; ++r) { SA0[r] = 0.f; SA1[r] = 0.f; }
    const int sj = tid >> 2, part = tid & 3;
    const float qs = ex2((float)sj * lg), ks = KSC * ex2(-(float)sj * lg), cdec = ex2(128.f * lg);
    const int slot = 32 * qi + ql;
    u32x4 rq[4], rk[4];
#define RET_GLOAD(c_) do { const int c__ = (c_); \
        const size_t row__ = (c__ >= 0) ? (size_t)b * SEQ + 128 * c__ + sj : (size_t)(MR + (sj >= 112 ? sj - 112 : 0)); \
        const bf16_t* p__ = proj + row__ * PJ + h * 128; \
        rq[0] = *(const u32x4*)(p__ + C_RQ + 16 * part); rq[1] = *(const u32x4*)(p__ + C_RQ + 16 * part + 8); rq[2] = *(const u32x4*)(p__ + C_RQ + 64 + 16 * part); rq[3] = *(const u32x4*)(p__ + C_RQ + 64 + 16 * part + 8); \
        rk[0] = *(const u32x4*)(p__ + C_RK + 16 * part); rk[1] = *(const u32x4*)(p__ + C_RK + 16 * part + 8); rk[2] = *(const u32x4*)(p__ + C_RK + 64 + 16 * part); rk[3] = *(const u32x4*)(p__ + C_RK + 64 + 16 * part + 8); } while (0)
    RET_GLOAD(-1);
    for (int c = -1; c < c_end; ++c) {
        const bool full = c >= c_full;
        {
            const bool valid = (c >= 0) || (sj >= 112);
            const float tpos = (float)((c >= 0) ? 16 + 128 * c + sj : (sj >= 112 ? sj - 112 : 0));
            u32x4 rv[4];
            { const size_t vrow = (c >= 0) ? (size_t)b * SEQ + 128 * c + sj : (size_t)(MR + (sj >= 112 ? sj - 112 : 0)); const bf16_t* vp = proj + vrow * PJ + C_RV + h * 128 + 32 * part;
#pragma unroll
              for (int q4 = 0; q4 < 4; ++q4) rv[q4] = *(const u32x4*)(vp + 8 * q4); }
#pragma unroll
            for (int hf = 0; hf < 2; ++hf) {
                float q1[8], q2[8], k1[8], k2[8];
#pragma unroll
                for (int e2 = 0; e2 < 4; ++e2) {
                    const unsigned uq1 = rq[hf][e2], uq2 = rq[2 + hf][e2], uk1 = rk[hf][e2], uk2 = rk[2 + hf][e2];
#pragma unroll
                    for (int o = 0; o < 2; ++o) {
                        const int e = 2 * e2 + o, pi = 16 * part + 8 * hf + e;
                        const float invf = ex2(-(float)pi * 0.20762050593046014f);
                        const float ang = tpos * invf;
                        const float fr = __builtin_amdgcn_fractf(ang * 0.15915494309189535f);
                        const float cc = __builtin_amdgcn_cosf(fr), sn = __builtin_amdgcn_sinf(fr);
                        const float a = o ? bfhi(uq1) : bflo(uq1), bb = o ? bfhi(uq2) : bflo(uq2), ka = o ? bfhi(uk1) : bflo(uk1), kb = o ? bfhi(uk2) : bflo(uk2);
                        q1[e] = (a * cc - bb * sn) * qs; q2[e] = (a * sn + bb * cc) * qs;
                        k1[e] = (ka * cc - kb * sn) * ks; k2[e] = (ka * sn + kb * cc) * ks;
                    }
                }
                if (!valid) {
#pragma unroll
                    for (int e = 0; e < 8; ++e) { q1[e] = 0.f; q2[e] = 0.f; k1[e] = 0.f; k2[e] = 0.f; }
                }
                if (full) {
                    *(LAS bf16x8*)(QI + sj * RP + 16 * part + 8 * hf) = pack8(q1[0], q1[1], q1[2], q1[3], q1[4], q1[5], q1[6], q1[7]);
                    *(LAS bf16x8*)(QI + sj * RP + 64 + 16 * part + 8 * hf) = pack8(q2[0], q2[1], q2[2], q2[3], q2[4], q2[5], q2[6], q2[7]);
                }
                *(LAS bf16x8*)(KI + sj * RP + 16 * part + 8 * hf) = pack8(k1[0], k1[1], k1[2], k1[3], k1[4], k1[5], k1[6], k1[7]);
                *(LAS bf16x8*)(KI + sj * RP + 64 + 16 * part + 8 * hf) = pack8(k2[0], k2[1], k2[2], k2[3], k2[4], k2[5], k2[6], k2[7]);
            }
#pragma unroll
            for (int q4 = 0; q4 < 4; ++q4) *(LAS u32x4*)(VI + sj * RPV + 32 * part + 8 * q4) = valid ? rv[q4] : zz;
        }
        __syncthreads();
        if (c + 1 < c_end) RET_GLOAD(c + 1);
        const bool qvalid = (c >= 0) || (slot >= 112 && b == 0);
        const size_t qrow = (c >= 0) ? (size_t)b * SEQ + 128 * c + slot : (size_t)(MR + (slot >= 112 ? slot - 112 : 0));
        f32x16 O0, O1;
#pragma unroll
        for (int r = 0; r < 16; ++r) { O0[r] = 0.f; O1[r] = 0.f; }
        if (full) {
        bf16x8 Qr[8];
#pragma unroll
        for (int d0 = 0; d0 < 8; ++d0) Qr[d0] = *(const LAS bf16x8*)(QI + slot * RP + 16 * d0 + 8 * hi);
#pragma unroll
        for (int d0 = 0; d0 < 8; ++d0) {
            const bf16x8 s0 = *(const LAS bf16x8*)(ST + (64 * eh + ql) * RP + 16 * d0 + 8 * hi), s1 = *(const LAS bf16x8*)(ST + (64 * eh + 32 + ql) * RP + 16 * d0 + 8 * hi);
            O0 = MFMA32(s0, Qr[d0], O0); O1 = MFMA32(s1, Qr[d0], O1);
        }
#pragma unroll
        for (int r = 0; r < 16; ++r) { O0[r] *= cdec; O1[r] *= cdec; }
        for (int jb = 0; jb <= qi; ++jb) {
            f32x16 sT;
#pragma unroll
            for (int r = 0; r < 16; ++r) sT[r] = 0.f;
#pragma unroll
            for (int d0 = 0; d0 < 8; ++d0) { const bf16x8 ka = *(const LAS bf16x8*)(KI + (32 * jb + ql) * RP + 16 * d0 + 8 * hi); sT = MFMA32(ka, Qr[d0], sT); }
            if (jb == qi) {
#pragma unroll
                for (int r = 0; r < 16; ++r) if (crow(r, hi) > ql) sT[r] = 0.f;
            }
            bf16x8 Pk[2];
            Pk[0] = pack8(sT[0], sT[1], sT[2], sT[3], sT[4], sT[5], sT[6], sT[7]);
            Pk[1] = pack8(sT[8], sT[9], sT[10], sT[11], sT[12], sT[13], sT[14], sT[15]);
#pragma unroll
            for (int s = 0; s < 2; ++s) {
                const LAS bf16_t* vb = VI + (32 * jb + 16 * s + 4 * hi + trq) * RPV + 64 * eh + 16 * trb + 4 * trp;
                const s16x4 l0 = vtr(vb), h0 = vtr(vb + 8 * RPV), l1 = vtr(vb + 32), h1 = vtr(vb + 8 * RPV + 32);
                const bf16x8 va0 = __builtin_shufflevector(l0, h0, 0, 1, 2, 3, 4, 5, 6, 7), va1 = __builtin_shufflevector(l1, h1, 0, 1, 2, 3, 4, 5, 6, 7);
                O0 = MFMA32(va0, Pk[s], O0); O1 = MFMA32(va1, Pk[s], O1);
            }
        }
        }
#pragma unroll
        for (int r = 0; r < 16; ++r) { SA0[r] *= cdec; SA1[r] *= cdec; }
#pragma unroll
        for (int js = 0; js < 8; ++js) {
            const LAS bf16_t* vb = VI + (16 * js + 8 * hi + trq) * RPV + 32 * eB + 16 * trb + 4 * trp;
            const LAS bf16_t* kb = KI + (16 * js + 8 * hi + trq) * RP + 32 * dB0 + 16 * trb + 4 * trp;
            const s16x4 vl = vtr(vb), vh = vtr(vb + 4 * RPV), k0l = vtr(kb), k0h = vtr(kb + 4 * RP), k1l = vtr(kb + 32), k1h = vtr(kb + 4 * RP + 32);
            const bf16x8 va = __builtin_shufflevector(vl, vh, 0, 1, 2, 3, 4, 5, 6, 7);
            const bf16x8 k0 = __builtin_shufflevector(k0l, k0h, 0, 1, 2, 3, 4, 5, 6, 7), k1 = __builtin_shufflevector(k1l, k1h, 0, 1, 2, 3, 4, 5, 6, 7);
            SA0 = MFMA32(va, k0, SA0); SA1 = MFMA32(va, k1, SA1);
        }
        if (!full) {
            __syncthreads();
            if (c + 1 >= c_full) {
#pragma unroll
                for (int r = 0; r < 16; ++r) {
                    ST[(32 * eB + crow(r, hi)) * RP + 32 * dB0 + ql] = (bf16_t)(pk2(SA0[r], 0.f) & 0xffffu);
                    ST[(32 * eB + crow(r, hi)) * RP + 32 * dB0 + 32 + ql] = (bf16_t)(pk2(SA1[r], 0.f) & 0xffffu);
                }
            }
            continue;
        }
        float s1 = 0.f, s2 = 0.f;
#pragma unroll
        for (int r = 0; r < 16; ++r) { s1 += O0[r] + O1[r]; s2 += O0[r] * O0[r] + O1[r] * O1[r]; }
        s1 += __shfl_xor(s1, 32); s2 += __shfl_xor(s2, 32);
        asm volatile("" ::: "memory");
        u32x2 ga[4], gb[4];
        {
            const bf16_t* gp = proj + qrow * PJ + C_RG + h * 128 + 64 * eh;
#pragma unroll
            for (int g = 0; g < 4; ++g) { ga[g] = *(const u32x2*)(gp + 8 * g + 4 * hi); gb[g] = *(const u32x2*)(gp + 32 + 8 * g + 4 * hi); }
        }
        __syncthreads();
#pragma unroll
        for (int r = 0; r < 16; ++r) {
            ST[(32 * eB + crow(r, hi)) * RP + 32 * dB0 + ql] = (bf16_t)(pk2(SA0[r], 0.f) & 0xffffu);
            ST[(32 * eB + crow(r, hi)) * RP + 32 * dB0 + 32 + ql] = (bf16_t)(pk2(SA1[r], 0.f) & 0xffffu);
        }
        if (hi == 0) { RED[(eh * 128 + slot) * 2] = s1; RED[(eh * 128 + slot) * 2 + 1] = s2; }
        __syncthreads();
        {
            const float t1 = RED[slot * 2] + RED[(128 + slot) * 2], t2 = RED[slot * 2 + 1] + RED[(128 + slot) * 2 + 1];
            const float mu = t1 * (1.f / 128.f), var = fmaxf(t2 * (1.f / 128.f) - mu * mu, 0.f), rstd = rsqrtf(var + EPS);
            if (qvalid) {
                bf16_t* op = mix + qrow * DM + 512 + h * 128 + 64 * eh; const float* gg = gn + h * 128 + 64 * eh;
#pragma unroll
                for (int g = 0; g < 4; ++g) {
                    const int e0 = 8 * g + 4 * hi;
                    const f32x4 na = *(const f32x4*)(gg + e0), nb = *(const f32x4*)(gg + 32 + e0);
                    const float y0 = (O0[4 * g] - mu) * rstd * na[0] * silu_f(bflo(ga[g].x)), y1 = (O0[4 * g + 1] - mu) * rstd * na[1] * silu_f(bfhi(ga[g].x));
                    const float y2 = (O0[4 * g + 2] - mu) * rstd * na[2] * silu_f(bflo(ga[g].y)), y3 = (O0[4 * g + 3] - mu) * rstd * na[3] * silu_f(bfhi(ga[g].y));
                    const float z0 = (O1[4 * g] - mu) * rstd * nb[0] * silu_f(bflo(gb[g].x)), z1 = (O1[4 * g + 1] - mu) * rstd * nb[1] * silu_f(bfhi(gb[g].x));
                    const float z2 = (O1[4 * g + 2] - mu) * rstd * nb[2] * silu_f(bflo(gb[g].y)), z3 = (O1[4 * g + 3] - mu) * rstd * nb[3] * silu_f(bfhi(gb[g].y));
                    u32x2 wa, wb; wa.x = pk2(y0, y1); wa.y = pk2(y2, y3); wb.x = pk2(z0, z1); wb.y = pk2(z2, z3);
                    *(u32x2*)(op + e0) = wa; *(u32x2*)(op + 32 + e0) = wb;
                }
            }
        }
    }
#undef RET_GLOAD
    __syncthreads();
}
#define XB_TMO      128
#define XB_XCNT(j)  (256  + 64 * (j))
#define XB_XSUB(j)  (1280 + 64 * (j))
#define XB_XGEN(j)  (2304 + 64 * (j))
#define XB_TOP      3328
#define XB_TOPGEN   3392
#define XCD_BAR_WORDS 3456
#define XB_SPIN_CAP (1u << 18)

__device__ __forceinline__ unsigned xb_ld(unsigned* p)              { return __hip_atomic_load(p, __ATOMIC_RELAXED, __HIP_MEMORY_SCOPE_AGENT); }
__device__ __forceinline__ unsigned xb_add(unsigned* p, unsigned v) { return __hip_atomic_fetch_add(p, v, __ATOMIC_RELAXED, __HIP_MEMORY_SCOPE_AGENT); }
__device__ __forceinline__ unsigned xb_xcc_id() { return (unsigned)__builtin_amdgcn_s_getreg((3 << 11) | 20) & 0xFu; }
#define XB_SPIN(cond, bar) do { unsigned _sp = 0; while (cond) { __builtin_amdgcn_s_sleep(1); \
    if ((++_sp & 255u) == 0u) { if (xb_ld(&(bar)[XB_TMO])) break; if (_sp > XB_SPIN_CAP) { atomicAdd(&(bar)[XB_TMO], 1u); break; } } } } while (0)

struct XcdBarrier {
    unsigned* bar; unsigned x;
    volatile LAS unsigned* st;
};

__device__ __forceinline__ XcdBarrier xcd_barrier_post(unsigned* bar, volatile LAS unsigned* st) {
    XcdBarrier b; b.bar = bar; b.x = xb_xcc_id(); b.st = st;
    if (threadIdx.x == 0) (void)xb_add(&bar[XB_XCNT(b.x)], 1u);
    return b;
}
__device__ __forceinline__ void xcd_barrier_complete(unsigned* bar, unsigned x, unsigned& nloc, unsigned& nx) {
    const unsigned G = gridDim.x * gridDim.y * gridDim.z;
    unsigned sum, cnt, mine, sp = 0u;
    for (;;) {
        sum = 0u; cnt = 0u; mine = 0u;
#pragma unroll
        for (unsigned j = 0; j < 16; ++j) { const unsigned c = xb_ld(&bar[XB_XCNT(j)]); sum += c; cnt += (c > 0u) ? 1u : 0u; mine = (j == x) ? c : mine; }
        if (sum == G) break;
        __builtin_amdgcn_s_sleep(1);
        if ((++sp & 255u) == 0u) { if (xb_ld(&bar[XB_TMO])) break; if (sp > XB_SPIN_CAP) { atomicAdd(&bar[XB_TMO], 1u); break; } }
    }
    nloc = mine > 0u ? mine : 1u; nx = cnt > 0u ? cnt : 1u;
}

__device__ __forceinline__ void xcd_barrier(const XcdBarrier& b) {
    asm volatile("s_waitcnt vmcnt(0)" ::: "memory");
    __syncthreads();
    if (threadIdx.x == 0) {
        unsigned* bar = b.bar;
        __builtin_amdgcn_s_waitcnt(0);
        unsigned nloc = b.st[0], nx = b.st[1];
        if (nloc == 0u) { xcd_barrier_complete(bar, b.x, nloc, nx); b.st[0] = nloc; b.st[1] = nx; }
        const unsigned old = xb_add(&bar[XB_XSUB(b.x)], 1u);
        const unsigned gen = old / nloc;
        if (old + 1u == (gen + 1u) * nloc) {
            __builtin_amdgcn_fence(__ATOMIC_RELEASE, "agent");
            asm volatile("s_waitcnt vmcnt(0)" ::: "memory");
            const unsigned og = xb_add(&bar[XB_TOP], 1u);
            const unsigned tg = og / nx;
            if (og + 1u == (tg + 1u) * nx) xb_add(&bar[XB_TOPGEN], 1u);
            else XB_SPIN(xb_ld(&bar[XB_TOPGEN]) == tg, bar);
            __builtin_amdgcn_fence(__ATOMIC_ACQUIRE, "agent");
            xb_add(&bar[XB_XGEN(b.x)], 1u);
            asm volatile("s_waitcnt vmcnt(0)" ::: "memory");
        } else {
            XB_SPIN(xb_ld(&bar[XB_XGEN(b.x)]) == gen, bar);
            __builtin_amdgcn_fence(__ATOMIC_ACQUIRE, "agent");
            asm volatile("s_waitcnt vmcnt(0)" ::: "memory");
        }
    }
    __syncthreads();
}

constexpr int Q_RET = NB * 4 * 2, Q_FOX = NB * 8 * 8, Q_META = 8, Q_ITEMS = Q_RET + Q_FOX + Q_META;
constexpr int LDS_ITEM = 147200, LDS_XB = 147216;
constexpr int CW_BAR = 4096;
__device__ __forceinline__ KAp kargs() { KAp p = (KAp)__builtin_amdgcn_kernarg_segment_ptr(); asm volatile("" : "+s"(p)); return p; }
__global__ void __launch_bounds__(512) hymba_fwd(KArgs a_unused) {
    extern __shared__ __attribute__((aligned(16))) unsigned char lds_raw[];
    LAS unsigned char* lds = (LAS unsigned char*)lds_raw;
    cg::grid_group grid = cg::this_grid();
    if (threadIdx.x < 2) ((volatile LAS unsigned*)(lds + LDS_XB))[threadIdx.x] = 0u;
    __syncthreads();
    (void)xcd_barrier_post((unsigned*)(kargs()->ws + WS_CTL) + CW_BAR, (volatile LAS unsigned*)(lds + LDS_XB));
#define GRID_BAR() do { XcdBarrier xb__; xb__.bar = (unsigned*)(kargs()->ws + WS_CTL) + CW_BAR; xb__.x = xb_xcc_id(); xb__.st = (volatile LAS unsigned*)(lds + LDS_XB); xcd_barrier(xb__); } while (0)
#define TID ((int)threadIdx.x)
#define LANE (TID & 63)
#define WAVE (__builtin_amdgcn_readfirstlane(TID >> 6))
#define GW ((int)blockIdx.x * 8 + WAVE)
#define NGW_ ((int)gridDim.x * 8)
    {
        KAp a = kargs();
        prologue(a, lds, GW, NGW_, WAVE, LANE);
    }
    if (gridDim.y == 0xFFFFu) grid.sync();
    GRID_BAR();

    for (int l = 0; l < 2; ++l) {
        {
            KAp ka = kargs(); unsigned char* ws = ka->ws;
            const bf16_t* hb = (const bf16_t*)(ws + WS_HB); const bf16_t* win = (const bf16_t*)(ws + WS_WIN + l * WIN_SZ);
            const float* ssq = (const float*)(ws + WS_SSQ) + (size_t)(2 * l) * MT; const float* bfg = ka->b_fgate + l * 8; float* lf = (float*)(ws + WS_LF); bf16_t* proj = (bf16_t*)(ws + WS_PROJ);
            int lane_ = LANE; asm volatile("" : "+v"(lane_)); const int lane = lane_, fq = lane >> 4;
            for (int t = GW; t < MR / 16 + 225; t += NGW_) {
                const bool real = t < MR / 16; const int mt = t - MR / 16;
                const bf16_t* A = hb + (size_t)(real ? 16 * t : MR) * DM; const bf16_t* Bn = win + (size_t)(real || mt == 224 ? 3584 : 16 * mt) * DM;
                const f32x4 acc = mini16<DM>(A, DM, Bn, lane);
                const int row = (real ? 16 * t : MR) + (lane & 15);
                const float rs = rsqrtf(ssq[row] * (1.f / DM) + EPS);
                if (real || mt == 224) {
                    if (fq < 2) {
#pragma unroll
                        for (int r = 0; r < 4; ++r) { const int hh = 4 * fq + r; lf[(size_t)hh * MT + row] = logsig2(acc[r] * rs + bfg[hh]); }
                    }
                } else {
                    u32x2 w; w.x = pk2(acc[0] * rs, acc[1] * rs); w.y = pk2(acc[2] * rs, acc[3] * rs);
                    *(u32x2*)(proj + (size_t)row * PJ + 16 * mt + 4 * fq) = w;
                }
            }
        }
        {
            KAp ka = kargs(); unsigned char* ws = ka->ws;
            pg8::Gemm g{(const bf16_t*)(ws + WS_HB), (const bf16_t*)(ws + WS_WIN + l * WIN_SZ), MR, PJ, DM}; pg8::StaticOrder S; S.init(MR, PJ, (int)gridDim.x, (int)blockIdx.x);
            EpiInProj E{(bf16_t*)(ws + WS_PROJ), (const float*)(ws + WS_SSQ) + (size_t)(2 * l) * MT};
            pg8::gemm_phase<EpiInProj, pg8::StaticOrder, PG8_ALIGN, PG8_SP2, DM>(lds, g, S, E);
        }
        GRID_BAR();
        {
            volatile LAS int* ITEM = (volatile LAS int*)(lds + LDS_ITEM);
            for (;;) {
                KAp ka = kargs(); unsigned char* ws = ka->ws;
                if (TID == 0) *ITEM = (int)__hip_atomic_fetch_add((unsigned*)(ws + WS_CTL) + 64 * l, 1u, __ATOMIC_RELAXED, __HIP_MEMORY_SCOPE_AGENT);
                __syncthreads();
                const int it = __builtin_amdgcn_readfirstlane(*ITEM);
                if (it >= (l == 0 ? Q_ITEMS : Q_ITEMS - Q_META)) break;
                const bf16_t* proj = (const bf16_t*)(ws + WS_PROJ); bf16_t* mix = (bf16_t*)(ws + WS_MIX);
                if (it < Q_RET) ret_unit(lds, proj, ka->ret_gn + l * 512, mix, (it & 63) >> 2, it & 3, it < 64 ? 1 : 0);
                else { const int k = it - Q_RET; fox_unit(lds, proj, (const float*)(ws + WS_LF), mix, (k & 127) >> 3, k & 7, 7 - (k >> 7)); }
            }
        }
        GRID_BAR();
        {
            KAp ka = kargs(); unsigned char* ws = ka->ws; float* out = ka->out; float* hmeta = (float*)(ws + WS_HMETA);
            const bf16_t* mixp = (const bf16_t*)(ws + WS_MIX); const bf16_t* wo = (const bf16_t*)(ws + WS_WOUT + l * WOUT_SZ); bf16_t* hb = (bf16_t*)(ws + WS_HB);
            float* ssq = (float*)(ws + WS_SSQ) + (size_t)(2 * l + 1) * MT;
            int lane_ = LANE; asm volatile("" : "+v"(lane_)); const int lane = lane_;
            if (l == 0)
            for (int t = GW; t < DM / 16; t += NGW_) {
                const f32x4 acc = mini16<DM>(mixp + (size_t)MR * DM, DM, wo + (size_t)16 * t * DM, lane);
                mini_resid(acc, l == 0 ? ka->meta : (const float*)hmeta, hmeta, hb, ssq, t, lane);
            }
        }
        {
            KAp ka = kargs(); unsigned char* ws = ka->ws; float* out = ka->out;
            pg8::Gemm g{(const bf16_t*)(ws + WS_MIX), (const bf16_t*)(ws + WS_WOUT + l * WOUT_SZ), MR, DM, DM}; pg8::StaticOrder S; S.init(MR, DM, (int)gridDim.x, (int)blockIdx.x);
            EpiResid E{(const float*)nullptr, (bf16_t*)(ws + WS_HB), (float*)(ws + WS_SSQ) + (size_t)(2 * l + 1) * MT};
            pg8::gemm_phase<EpiResid, pg8::StaticOrder, PG8_ALIGN, PG8_SP2, DM>(lds, g, S, E);
        }
        GRID_BAR();
        {
            KAp ka = kargs(); unsigned char* ws = ka->ws;
            const bf16_t* hb = (const bf16_t*)(ws + WS_HB); const bf16_t* wgu = (const bf16_t*)(ws + WS_WGU + l * WGU_SZ); bf16_t* ff = (bf16_t*)(ws + WS_PROJ);
            const float* ssq = (const float*)(ws + WS_SSQ) + (size_t)(2 * l + 1) * MT;
            int lane_ = LANE; asm volatile("" : "+v"(lane_)); const int lane = lane_;
            if (l == 0)
            for (int t = GW; t < DFF / 16; t += NGW_) {
                const int f0 = 16 * t, nr = 256 * (f0 >> 7) + (f0 & 127);
                const f32x4 ag = mini16<DM>(hb + (size_t)MR * DM, DM, wgu + (size_t)nr * DM, lane), au = mini16<DM>(hb + (size_t)MR * DM, DM, wgu + (size_t)(nr + 128) * DM, lane);
                const int j = lane & 15; const float rs = rsqrtf(ssq[MR + j] * (1.f / DM) + EPS);
                u32x2 w; w.x = pk2(silu_f(ag[0] * rs) * (au[0] * rs), silu_f(ag[1] * rs) * (au[1] * rs)); w.y = pk2(silu_f(ag[2] * rs) * (au[2] * rs), silu_f(ag[3] * rs) * (au[3] * rs));
                *(u32x2*)(ff + (size_t)(MR + j) * DFF + f0 + 4 * (lane >> 4)) = w;
            }
        }
        {
            KAp ka = kargs(); unsigned char* ws = ka->ws;
            pg8::Gemm g{(const bf16_t*)(ws + WS_HB), (const bf16_t*)(ws + WS_WGU + l * WGU_SZ), MR, NGU, DM}; pg8::StaticOrder S; S.init(MR, NGU, (int)gridDim.x, (int)blockIdx.x);
            EpiSwiGLU E{(bf16_t*)(ws + WS_PROJ), (const float*)(ws + WS_SSQ) + (size_t)(2 * l + 1) * MT};
            pg8::gemm_phase<EpiSwiGLU, pg8::StaticOrder, PG8_ALIGN, PG8_SP2, DM>(lds, g, S, E);
        }
        GRID_BAR();
        {
            KAp ka = kargs(); unsigned char* ws = ka->ws; float* out = ka->out; float* hmeta = (float*)(ws + WS_HMETA);
            const bf16_t* ff = (const bf16_t*)(ws + WS_PROJ); const bf16_t* wd = (const bf16_t*)(ws + WS_WD + l * WD_SZ); bf16_t* hb = (bf16_t*)(ws + WS_HB);
            float* ssq = (float*)(ws + WS_SSQ) + (size_t)(2 * l + 2) * MT;
            int lane_ = LANE; asm volatile("" : "+v"(lane_)); const int lane = lane_;
            if (l == 0)
            for (int t = GW; t < DM / 16; t += NGW_) {
                const f32x4 acc = mini16<DFF>(ff + (size_t)MR * DFF, DFF, wd + (size_t)16 * t * DFF, lane);
                mini_resid(acc, (const float*)hmeta, hmeta, hb, ssq, t, lane);
            }
        }
        if (l == 0) {
            KAp ka = kargs(); unsigned char* ws = ka->ws; float* out = ka->out;
            pg8::Gemm g{(const bf16_t*)(ws + WS_PROJ), (const bf16_t*)(ws + WS_WD + l * WD_SZ), MR, DM, DFF}; pg8::StaticOrder S; S.init(MR, DM, (int)gridDim.x, (int)blockIdx.x);
            EpiResid E{(const float*)nullptr, (bf16_t*)(ws + WS_HB), (float*)(ws + WS_SSQ) + (size_t)(2 * l + 2) * MT};
            pg8::gemm_phase<EpiResid, pg8::StaticOrder, PG8_ALIGN, PG8_SP2, DFF>(lds, g, S, E);
            GRID_BAR();
        } else {
            KAp ka = kargs(); unsigned char* ws = ka->ws; float* out = ka->out;
            pg8::Gemm g{(const bf16_t*)(ws + WS_PROJ), (const bf16_t*)(ws + WS_WD + l * WD_SZ), MR, DM, DFF}; pg8::StaticOrder S; S.init(MR, DM, (int)gridDim.x, (int)blockIdx.x);
            EpiResidNorm E{(const bf16_t*)(ws + WS_HB), out, ka->final_norm, (float*)(ws + WS_XBUF), (unsigned*)(ws + WS_CTL) + CW_CNT, lds + LDS_XCH};
            pg8::gemm_phase<EpiResidNorm, pg8::StaticOrder, true, PG8_SP2, DFF>(lds, g, S, E);
        }
    }
}

extern "C" void kernel_launch(void* const* d_in, const int* in_sizes, int n_in, void* d_out, int out_size, void* d_ws, size_t ws_size, hipStream_t stream) {
    static int grid = 0;
    if (grid == 0) {
        if (n_in != 12 || in_sizes[0] != MR * DM || out_size != MR * DM || ws_size < WS_END) { fprintf(stderr, "kernel_launch: unexpected shapes (n_in %d, in0 %d, out %d, ws %zu)\n", n_in, n_in > 0 ? in_sizes[0] : -1, out_size, ws_size); grid = -1; return; }
        int dev = 0, cus = 0, per_cu = 0;
        if (hipGetDevice(&dev) != hipSuccess || hipDeviceGetAttribute(&cus, hipDeviceAttributeMultiprocessorCount, dev) != hipSuccess) { grid = -1; return; }
        if (hipFuncSetAttribute((const void*)hymba_fwd, hipFuncAttributeMaxDynamicSharedMemorySize, LDS_BYTES) != hipSuccess) { fprintf(stderr, "kernel_launch: hipFuncSetAttribute failed\n"); grid = -1; return; }
        if (hipOccupancyMaxActiveBlocksPerMultiprocessor(&per_cu, (const void*)hymba_fwd, 512, LDS_BYTES) != hipSuccess || per_cu < 1) { fprintf(stderr, "kernel_launch: occupancy query reports %d blocks per CU\n", per_cu); grid = -1; return; }
        (void)hipGetLastError();
        grid = cus;
    }
    if (grid < 0) return;
    if (hipMemsetAsync((char*)d_ws + WS_CTL, 0, CTL_BYTES, stream) != hipSuccess) { fprintf(stderr, "kernel_launch: memset failed\n"); return; }
    KArgs a{};
    a.x = (const float*)d_in[0]; a.meta = (const float*)d_in[1]; a.attn_norm = (const float*)d_in[2]; a.w_in = (const float*)d_in[3]; a.b_fgate = (const float*)d_in[4];
    a.ret_gn = (const float*)d_in[5]; a.w_out = (const float*)d_in[6]; a.ffn_norm = (const float*)d_in[7]; a.w_gate = (const float*)d_in[8]; a.w_up = (const float*)d_in[9];
    a.w_down = (const float*)d_in[10]; a.final_norm = (const float*)d_in[11]; a.out = (float*)d_out; a.ws = (unsigned char*)d_ws;
    void* args[] = {&a};
    const hipError_t e = hipLaunchCooperativeKernel((const void*)hymba_fwd, dim3(grid), dim3(512), args, LDS_BYTES, stream);
    if (e != hipSuccess) fprintf(stderr, "kernel_launch: cooperative launch failed: %s (grid %d)\n", hipGetErrorString(e), grid);
}
```

```cpp
#include <hip/hip_runtime.h>
#include <hip/hip_cooperative_groups.h>
#include <cstdio>
#include <cstdint>
namespace cg = cooperative_groups;
namespace pg8 {
#define PG8_LAS __attribute__((address_space(3)))
typedef unsigned short bf16_t;
typedef short bf16x8 __attribute__((ext_vector_type(8)));
typedef float f32x4 __attribute__((ext_vector_type(4)));
typedef unsigned u32x4 __attribute__((ext_vector_type(4)));
constexpr int BM = 256, BK = 64, HALF = 128, HTB = HALF * BK * 2  , STAGE_BYTES = 8 * HTB, NXCD = 8, WGM = 4;

__host__ __device__ __forceinline__ int lds_byte(int r, int c) { const int st = (r >> 4) * 2 + (c >> 5), rr = r & 15, cc = c & 31, ob = rr * 64 + cc * 2; return st * 1024 + (ob ^ (((ob >> 9) & 1) << 5)); }
__host__ __device__ __forceinline__ void stage_rc(int b, int& R, int& C) { const int st = b / 1024, sb = b % 1024, swz = sb ^ (((sb >> 9) & 1) << 5); R = (st >> 1) * 16 + swz / 64; C = (st & 1) * 32 + (swz % 64) / 2; }
__host__ __device__ __forceinline__ int perm32(int rho) { const int n = rho >> 4, i = rho & 15; return 8 * (i >> 2) + 4 * n + (i & 3); }

struct Unit { int pm, pn; };
struct Gemm { const bf16_t* A; const bf16_t* Bt; int M, N, K; };

struct StaticOrder {
    int nM, nN, nwg, G, c;
    __host__ __device__ void init(int M, int N, int G_, int c_) { nM = M / BM; nN = N / BM; nwg = nM * nN; G = G_; c = c_; }
    __host__ __device__ bool next(int i, Unit& u) const {
        const long L = (long)i * G + c; if (L >= nwg) return false;
        int wgid = (int)L; { const int q = nwg / NXCD, r = nwg % NXCD, xcd = wgid % NXCD, off = wgid / NXCD; wgid = (xcd < r ? xcd * (q + 1) : r * (q + 1) + (xcd - r) * q) + off; }
        const int nig = WGM * nN, gid = wgid / nig, fm = gid * WGM, gsz = (nM - fm) < WGM ? (nM - fm) : WGM;
        u.pm = fm + ((wgid % nig) % gsz); u.pn = (wgid % nig) / gsz; return true;
    }
    __device__ __forceinline__ void a_ready(const Unit&) const {}
    __device__ __forceinline__ void done(const Unit&) const {}
};

template <class Epi, class Sched, bool ALIGN_EPI, bool SP2, int KC>
__device__ __forceinline__ void gemm_phase(PG8_LAS unsigned char* lds, const Gemm g, const Sched& S, const Epi& E) {
    int tid_ = threadIdx.x; asm volatile("" : "+v"(tid_));
    const int tid = tid_, wid = __builtin_amdgcn_readfirstlane(tid >> 6), lane = tid & 63, wr = wid >> 2, wc = wid & 3, fr = lane & 15, fq = lane >> 4;
    constexpr int K = KC, nt = K / BK;
    unsigned voffA[2], voffB[2];
#pragma unroll
    for (int i = 0; i < 2; ++i) { int R, C; stage_rc(tid * 16 + i * 8192, R, C); const int Rb = Epi::PERM ? ((R & ~31) + perm32(R & 31)) : R;
        voffA[i] = (unsigned)(R * K + C) * 2u; voffB[i] = (unsigned)(Rb * K + C) * 2u; }
    const size_t kstep = (size_t)(BK * 2);
    const size_t hstep = (size_t)HALF * K * 2;
    const size_t tstep = 2 * hstep;
    const unsigned ldsw = (unsigned)wid * 1024u;
    const int aoff = lds_byte(wr * 64 + fr, fq * 8), boff = lds_byte(wc * 32 + fr, fq * 8);
#define PG8_SA(b, h) (((b) * 2 + (h)) * HTB)
#define PG8_SB(b, h) ((4 + (b) * 2 + (h)) * HTB)
#define PG8_STAGE(bufoff, gbase, voff) do { _Pragma("unroll") for (int _i = 0; _i < 2; ++_i) \
        __builtin_amdgcn_global_load_lds((const unsigned*)((const char*)(gbase) + (voff)[_i]), (PG8_LAS unsigned*)(lds + (bufoff) + ldsw + _i * 8192), 16, 0, 0); } while (0)
#define PG8_LDA(dst, b, h) do { _Pragma("unroll") for (int m = 0; m < 4; ++m) _Pragma("unroll") for (int k = 0; k < 2; ++k) dst[m][k] = *(const PG8_LAS bf16x8*)(lds + PG8_SA(b, h) + aoff + m * 2048 + k * 1024); } while (0)
#define PG8_LDB(dst, b, h) do { _Pragma("unroll") for (int n = 0; n < 2; ++n) _Pragma("unroll") for (int k = 0; k < 2; ++k) dst[n][k] = *(const PG8_LAS bf16x8*)(lds + PG8_SB(b, h) + boff + n * 2048 + k * 1024); } while (0)
#define PG8_MMA(ai, bj, At, Bt) do { __builtin_amdgcn_s_setprio(1); _Pragma("unroll") for (int m = 0; m < 4; ++m) _Pragma("unroll") for (int n = 0; n < 2; ++n) _Pragma("unroll") for (int k = 0; k < 2; ++k) \
        acc[ai][bj][m][n] = __builtin_amdgcn_mfma_f32_16x16x32_bf16(Bt[n][k], At[m][k], acc[ai][bj][m][n], 0, 0, 0); __builtin_amdgcn_s_setprio(0); } while (0)
#define PG8_WAIT_V(n) asm volatile("s_waitcnt vmcnt(" #n ")" ::: "memory")
#define PG8_WAIT_L(n) asm volatile("s_waitcnt lgkmcnt(" #n ")" ::: "memory")
#define PG8_BAR __builtin_amdgcn_s_barrier()
#define PG8_SCHED __builtin_amdgcn_sched_barrier(0)
    Unit cur, nxt; int ui = 0;
    if (!S.next(0, cur)) return;
    f32x4 acc[2][2][4][2];
#pragma unroll
    for (int a = 0; a < 2; ++a)
#pragma unroll
        for (int b = 0; b < 2; ++b)
#pragma unroll
            for (int m = 0; m < 4; ++m)
#pragma unroll
                for (int n = 0; n < 2; ++n) acc[a][b][m][n] = (f32x4){0.f, 0.f, 0.f, 0.f};
    bf16x8 At[4][2], B0[2][2], B1[2][2];
    const char* cA = (const char*)g.A + (size_t)cur.pm * tstep; const char* cB = (const char*)g.Bt + (size_t)cur.pn * tstep;
    S.a_ready(cur);
    if constexpr (SP2) {
        PG8_STAGE(PG8_SB(0, 0), cB, voffB); PG8_STAGE(PG8_SB(0, 1), cB + hstep, voffB); PG8_STAGE(PG8_SA(0, 0), cA, voffA); PG8_STAGE(PG8_SA(0, 1), cA + hstep, voffA);
        if (wr == 1) PG8_BAR;
        PG8_WAIT_V(2); PG8_BAR;
        PG8_STAGE(PG8_SB(1, 0), cB + kstep, voffB); PG8_STAGE(PG8_SA(1, 0), cA + kstep, voffA); PG8_STAGE(PG8_SB(1, 1), cB + hstep + kstep, voffB);
        PG8_WAIT_V(6); PG8_BAR;
    } else {
        PG8_STAGE(PG8_SB(0, 0), cB, voffB); PG8_STAGE(PG8_SA(0, 0), cA, voffA); PG8_STAGE(PG8_SB(0, 1), cB + hstep, voffB); PG8_STAGE(PG8_SA(0, 1), cA + hstep, voffA);
        if (wr == 1) PG8_BAR;
        PG8_WAIT_V(4); PG8_BAR;
        PG8_STAGE(PG8_SB(1, 0), cB + kstep, voffB); PG8_STAGE(PG8_SA(1, 0), cA + kstep, voffA); PG8_STAGE(PG8_SB(1, 1), cB + hstep + kstep, voffB);
        PG8_WAIT_V(6); PG8_BAR;
    }
    for (;;) {
        const bool has_next = S.next(ui + 1, nxt);
        const char* nA = has_next ? (const char*)g.A + (size_t)nxt.pm * tstep : cA; const char* nB = has_next ? (const char*)g.Bt + (size_t)nxt.pn * tstep : cB;
        for (int t = 0; t < nt; t += 2) {
            const bool last = (t == nt - 2);
            const char* a1 = cA + (size_t)(t + 1) * kstep;
            const char* a2 = last ? nA : cA + (size_t)(t + 2) * kstep; const char* b2 = last ? nB : cB + (size_t)(t + 2) * kstep;
            const char* a3 = a2 + kstep; const char* b3 = b2 + kstep;
            if (last && has_next) S.a_ready(nxt);
            if constexpr (SP2) {
            PG8_LDB(B0, 0, 0); PG8_LDB(B1, 0, 1); PG8_SCHED; PG8_LDA(At, 0, 0); PG8_STAGE(PG8_SA(1, 1), a1 + hstep, voffA);
            PG8_WAIT_V(8); PG8_WAIT_L(0); PG8_BAR; PG8_MMA(0, 0, At, B0); PG8_MMA(0, 1, At, B1); PG8_BAR; PG8_SCHED;
            PG8_LDA(At, 0, 1); PG8_STAGE(PG8_SB(0, 0), b2, voffB); PG8_STAGE(PG8_SB(0, 1), b2 + hstep, voffB); PG8_STAGE(PG8_SA(0, 0), a2, voffA);
            PG8_WAIT_V(8); PG8_WAIT_L(0); PG8_BAR; PG8_MMA(1, 0, At, B0); PG8_MMA(1, 1, At, B1); PG8_BAR; PG8_SCHED;
            PG8_LDB(B0, 1, 0); PG8_LDB(B1, 1, 1); PG8_SCHED; PG8_LDA(At, 1, 0); PG8_STAGE(PG8_SA(0, 1), a2 + hstep, voffA);
            PG8_WAIT_V(8); PG8_WAIT_L(0); PG8_BAR; PG8_MMA(0, 0, At, B0); PG8_MMA(0, 1, At, B1); PG8_BAR; PG8_SCHED;
            PG8_LDA(At, 1, 1); PG8_STAGE(PG8_SB(1, 0), b3, voffB); PG8_STAGE(PG8_SB(1, 1), b3 + hstep, voffB); PG8_STAGE(PG8_SA(1, 0), a3, voffA);
            PG8_WAIT_V(8); PG8_WAIT_L(0); PG8_BAR; PG8_MMA(1, 0, At, B0); PG8_MMA(1, 1, At, B1); PG8_BAR; PG8_SCHED;
            } else {
            PG8_LDB(B0, 0, 0); PG8_SCHED; PG8_LDA(At, 0, 0); PG8_STAGE(PG8_SA(1, 1), a1 + hstep, voffA);
            PG8_WAIT_L(8); PG8_BAR; PG8_WAIT_L(0); PG8_MMA(0, 0, At, B0); PG8_BAR; PG8_SCHED;
            PG8_LDB(B1, 0, 1); PG8_STAGE(PG8_SB(0, 0), b2, voffB);
            PG8_BAR; PG8_WAIT_L(0); PG8_MMA(0, 1, At, B1); PG8_BAR;
            PG8_LDA(At, 0, 1); PG8_STAGE(PG8_SA(0, 0), a2, voffA);
            PG8_BAR; PG8_WAIT_L(0); PG8_MMA(1, 0, At, B0); PG8_BAR; PG8_SCHED;
            PG8_STAGE(PG8_SB(0, 1), b2 + hstep, voffB);
            PG8_WAIT_V(6); PG8_BAR; PG8_MMA(1, 1, At, B1); PG8_BAR;
            PG8_LDB(B0, 1, 0); PG8_SCHED; PG8_LDA(At, 1, 0); PG8_STAGE(PG8_SA(0, 1), a2 + hstep, voffA);
            PG8_WAIT_L(8); PG8_BAR; PG8_WAIT_L(0); PG8_MMA(0, 0, At, B0); PG8_BAR; PG8_SCHED;
            PG8_LDB(B1, 1, 1); PG8_STAGE(PG8_SB(1, 0), b3, voffB);
            PG8_BAR; PG8_WAIT_L(0); PG8_MMA(0, 1, At, B1); PG8_BAR;
            PG8_LDA(At, 1, 1); PG8_STAGE(PG8_SA(1, 0), a3, voffA);
            PG8_BAR; PG8_WAIT_L(0); PG8_MMA(1, 0, At, B0); PG8_BAR; PG8_SCHED;
            PG8_STAGE(PG8_SB(1, 1), b3 + hstep, voffB);
            PG8_WAIT_V(6); PG8_BAR; PG8_MMA(1, 1, At, B1); PG8_BAR;
            }
        }
        if constexpr (ALIGN_EPI) { if (wr == 0) PG8_BAR; }
        if constexpr (!Epi::AFTER_DRAIN) { E(acc, cur, wr, wc, fr, fq); S.done(cur); }
        if (!has_next) break;
#pragma unroll
        for (int a = 0; a < 2; ++a)
#pragma unroll
            for (int b = 0; b < 2; ++b)
#pragma unroll
                for (int m = 0; m < 4; ++m)
#pragma unroll
                    for (int n = 0; n < 2; ++n) acc[a][b][m][n] = (f32x4){0.f, 0.f, 0.f, 0.f};
        cur = nxt; cA = nA; cB = nB; ++ui;
        if constexpr (ALIGN_EPI) { if (wr == 1) PG8_BAR; }
    }
    PG8_WAIT_V(0);
    if constexpr (!ALIGN_EPI) { if (wr == 0) PG8_BAR; }
    PG8_BAR;
    if constexpr (Epi::AFTER_DRAIN) { E.fused(acc, cur, wr, wc, fr, fq, lds, wid, lane); S.done(cur); }
#undef PG8_SA
#undef PG8_SB
#undef PG8_STAGE
#undef PG8_LDA
#undef PG8_LDB
#undef PG8_MMA
#undef PG8_WAIT_V
#undef PG8_WAIT_L
#undef PG8_BAR
#undef PG8_SCHED
}
}
#ifndef PG8_SP2
#define PG8_SP2 true
#endif
#ifndef PG8_ALIGN
#define PG8_ALIGN true
#endif
#define LAS __attribute__((address_space(3)))
typedef unsigned short bf16_t;
typedef short bf16x8 __attribute__((ext_vector_type(8)));
typedef short s16x4 __attribute__((ext_vector_type(4)));
typedef float f32x2 __attribute__((ext_vector_type(2)));
typedef float f32x4 __attribute__((ext_vector_type(4)));
typedef float f32x16 __attribute__((ext_vector_type(16)));
typedef unsigned u32x2 __attribute__((ext_vector_type(2)));
typedef unsigned u32x4 __attribute__((ext_vector_type(4)));
typedef __bf16 bf16x2_t __attribute__((ext_vector_type(2)));

constexpr int NB = 16, SEQ = 2048, NMETA = 16, DM = 1024, MR = NB * SEQ, MT = MR + NB * NMETA;
constexpr int PJ = 3584, NPJ = 3616, DFF = 2816, NGU = 2 * DFF;
constexpr int C_FQ = 0, C_FK = 512, C_FV = 1024, C_RQ = 1536, C_RK = 2048, C_RV = 2560, C_RG = 3072;
constexpr float EPS = 1e-6f, LOG2E = 1.4426950408889634f;
constexpr size_t MiB = 1u << 20;
constexpr size_t WS_CTL = 0, CTL_BYTES = 1 * MiB, WS_SSQ = 65536;
constexpr size_t WS_WIN = 1 * MiB, WS_WOUT = 16 * MiB, WS_WGU = 20 * MiB, WS_WD = 42 * MiB, WS_CS = 53 * MiB, WS_LF = 55 * MiB, WS_HMETA = 57 * MiB;
constexpr size_t WS_HB = 58 * MiB, WS_MIX = 123 * MiB, WS_PROJ = 188 * MiB, WS_END = 414 * MiB;
constexpr size_t WIN_SZ = (size_t)NPJ * DM * 2, WOUT_SZ = (size_t)DM * DM * 2, WGU_SZ = (size_t)NGU * DM * 2, WD_SZ = (size_t)DM * DFF * 2;
static_assert(WS_WIN + 2 * WIN_SZ <= WS_WOUT && WS_WOUT + 2 * WOUT_SZ <= WS_WGU && WS_WGU + 2 * WGU_SZ <= WS_WD && WS_WD + 2 * WD_SZ <= WS_CS, "ws map (weights)");
static_assert(WS_CS + (size_t)2064 * 64 * 8 <= WS_LF && WS_LF + (size_t)8 * MT * 4 <= WS_HMETA && WS_HB + (size_t)MT * DM * 2 <= WS_MIX && WS_MIX + (size_t)MT * DM * 2 <= WS_PROJ && WS_PROJ + (size_t)MT * PJ * 2 <= WS_END, "ws map");
static_assert(WS_SSQ + 5 * (size_t)MT * 4 <= CTL_BYTES, "ssq inside the memset region");
constexpr int LDS_BYTES = 147456, LDS_XCH = 131072;
constexpr size_t WS_XBUF = WS_HMETA + 512 * 1024;
constexpr int CW_CNT = 204800;

__device__ __forceinline__ unsigned pk2(float lo, float hi) { f32x2 v = {lo, hi}; bf16x2_t b = __builtin_convertvector(v, bf16x2_t); return __builtin_bit_cast(unsigned, b); }
__device__ __forceinline__ float bflo(unsigned u) { return __uint_as_float(u << 16); }
__device__ __forceinline__ float bfhi(unsigned u) { return __uint_as_float(u & 0xffff0000u); }
__device__ __forceinline__ float bf1(short s) { return __uint_as_float(((unsigned)(unsigned short)s) << 16); }
__device__ __forceinline__ bf16x8 pack8(float a, float b, float c, float d, float e, float f, float g, float h) { u32x4 p; p.x = pk2(a, b); p.y = pk2(c, d); p.z = pk2(e, f); p.w = pk2(g, h); return __builtin_bit_cast(bf16x8, p); }
__device__ __forceinline__ int crow(int r, int hi) { return (r & 3) + 8 * (r >> 2) + 4 * hi; }
__device__ __forceinline__ float ex2(float x) { return __builtin_amdgcn_exp2f(x); }
__device__ __forceinline__ float silu_f(float g) { return g * __builtin_amdgcn_rcpf(1.f + ex2(-g * LOG2E)); }
__device__ __forceinline__ float wave_sum(float v) {
#pragma unroll
    for (int o = 1; o < 64; o <<= 1) v += __shfl_xor(v, o);
    return v;
}
#define MFMA32(a, b, c) __builtin_amdgcn_mfma_f32_32x32x16_bf16((a), (b), (c), 0, 0, 0)

struct EpiInProj {
    static constexpr bool PERM = true, AFTER_DRAIN = false;
    bf16_t* proj; const float* ssq;
    __device__ __forceinline__ void operator()(const f32x4 (&acc)[2][2][4][2], const pg8::Unit& u, int wr, int wc, int fr, int fq) const {
        const int row0 = u.pm * 256 + wr * 64 + fr;
        {
            const int col0 = u.pn * 256 + wc * 32 + 8 * fq;
#pragma unroll
            for (int ai = 0; ai < 2; ++ai)
#pragma unroll
                for (int m = 0; m < 4; ++m) {
                    const int row = row0 + ai * 128 + m * 16;
                    const float rs = rsqrtf(ssq[row] * (1.f / DM) + EPS);
                    bf16_t* rp = proj + (size_t)row * PJ + col0;
#pragma unroll
                    for (int bj = 0; bj < 2; ++bj) {
                        const f32x4 v0 = acc[ai][bj][m][0] * rs, v1 = acc[ai][bj][m][1] * rs;
                        u32x4 w; w.x = pk2(v0[0], v0[1]); w.y = pk2(v0[2], v0[3]); w.z = pk2(v1[0], v1[1]); w.w = pk2(v1[2], v1[3]);
                        *(u32x4*)(rp + bj * 128) = w;
                    }
                }
        }
    }
};
struct EpiResid {
    static constexpr bool PERM = false, AFTER_DRAIN = false;
    const float* in_f32; bf16_t* hb; float* ssq;
    __device__ __forceinline__ void operator()(const f32x4 (&acc)[2][2][4][2], const pg8::Unit& u, int wr, int wc, int fr, int fq) const {
        const int col0 = u.pn * 256 + wc * 32 + 4 * fq;
#pragma unroll
        for (int ai = 0; ai < 2; ++ai)
#pragma unroll
            for (int m = 0; m < 4; ++m) {
                const int row = u.pm * 256 + ai * 128 + wr * 64 + m * 16 + fr;
                bf16_t* bp = hb + (size_t)row * DM;
                float ss = 0.f;
#pragma unroll
                for (int bj = 0; bj < 2; ++bj)
#pragma unroll
                    for (int n = 0; n < 2; ++n) {
                        const int c = col0 + bj * 128 + n * 16;
                        f32x4 hv;
                        if (in_f32) hv = *(const f32x4*)(in_f32 + (size_t)row * DM + c);
                        else { const u32x2 hw = *(const u32x2*)(bp + c); hv = (f32x4){bflo(hw.x), bfhi(hw.x), bflo(hw.y), bfhi(hw.y)}; }
                        const f32x4 o = hv + acc[ai][bj][m][n];
                        u32x2 w; w.x = pk2(o[0], o[1]); w.y = pk2(o[2], o[3]);
                        *(u32x2*)(bp + c) = w;
                        ss += (o[0] * o[0] + o[1] * o[1]) + (o[2] * o[2] + o[3] * o[3]);
                    }
                ss += __shfl_xor(ss, 16); ss += __shfl_xor(ss, 32);
                if (fq == 0) (void)__hip_atomic_fetch_add(ssq + row, ss, __ATOMIC_RELAXED, __HIP_MEMORY_SCOPE_AGENT);
                if (m & 1) asm volatile("" ::: "memory");
            }
    }
};
struct EpiResidNorm {
    static constexpr bool PERM = false, AFTER_DRAIN = false;
    const bf16_t* in_hb; float* out_real; const float* gain; float* xbuf; unsigned* cnt; LAS unsigned char* sc;
    __device__ __forceinline__ void operator()(f32x4 (&acc)[2][2][4][2], const pg8::Unit& u, int wr, int wc, int fr, int fq) const {
        LAS float* P = (LAS float*)sc;
        LAS float* S = (LAS float*)(sc + 4096);
        const int lane = threadIdx.x & 63, wid = wr * 4 + wc;
        const int col0 = u.pn * 256 + wc * 32 + 4 * fq;
#pragma unroll
        for (int ai = 0; ai < 2; ++ai)
#pragma unroll
            for (int m = 0; m < 4; ++m) {
                const int rl = ai * 128 + wr * 64 + m * 16 + fr;
                const bf16_t* ip = in_hb + (size_t)(u.pm * 256 + rl) * DM;
                float ss = 0.f;
#pragma unroll
                for (int bj = 0; bj < 2; ++bj)
#pragma unroll
                    for (int n = 0; n < 2; ++n) {
                        const u32x2 hw = *(const u32x2*)(ip + col0 + bj * 128 + n * 16);
                        const f32x4 o = (f32x4){bflo(hw.x), bfhi(hw.x), bflo(hw.y), bfhi(hw.y)} + acc[ai][bj][m][n];
                        acc[ai][bj][m][n] = o;
                        ss += (o[0] * o[0] + o[1] * o[1]) + (o[2] * o[2] + o[3] * o[3]);
                    }
                ss += __shfl_xor(ss, 16); ss += __shfl_xor(ss, 32);
                if (fq == 0) P[rl * 4 + wc] = ss;
                if (m & 1) asm volatile("" ::: "memory");
            }
        asm volatile("s_waitcnt lgkmcnt(0)" ::: "memory"); __builtin_amdgcn_s_barrier(); asm volatile("" ::: "memory");
        const int rowp = wid * 32 + (lane & 31);
        if (lane < 32) {
            const float t = (P[rowp * 4] + P[rowp * 4 + 1]) + (P[rowp * 4 + 2] + P[rowp * 4 + 3]);
            __hip_atomic_store(xbuf + (size_t)(u.pm * 256 + rowp) * 4 + u.pn, t, __ATOMIC_RELAXED, __HIP_MEMORY_SCOPE_AGENT);
        }
        asm volatile("s_waitcnt vmcnt(0)" ::: "memory");
        if (lane == 0) (void)__hip_atomic_fetch_add(cnt + 64 * u.pm, 1u, __ATOMIC_RELAXED, __HIP_MEMORY_SCOPE_AGENT);
        if (wid == 0) {
            unsigned spins = 0;
            while ((unsigned)__builtin_amdgcn_readfirstlane(__hip_atomic_load(cnt + 64 * u.pm, __ATOMIC_RELAXED, __HIP_MEMORY_SCOPE_AGENT)) < 32u) { __builtin_amdgcn_s_sleep(2); if (++spins > (1u << 20)) break; }
            __builtin_amdgcn_fence(__ATOMIC_ACQUIRE, "agent");
        }
        asm volatile("s_waitcnt vmcnt(0) lgkmcnt(0)" ::: "memory"); __builtin_amdgcn_s_barrier(); asm volatile("" ::: "memory");
        if (lane < 32) {
            const float* slot = xbuf + (size_t)(u.pm * 256 + rowp) * 4;
            const float t = (__hip_atomic_load(slot, __ATOMIC_RELAXED, __HIP_MEMORY_SCOPE_AGENT) + __hip_atomic_load(slot + 1, __ATOMIC_RELAXED, __HIP_MEMORY_SCOPE_AGENT))
                          + (__hip_atomic_load(slot + 2, __ATOMIC_RELAXED, __HIP_MEMORY_SCOPE_AGENT) + __hip_atomic_load(slot + 3, __ATOMIC_RELAXED, __HIP_MEMORY_SCOPE_AGENT));
            S[rowp] = rsqrtf(t * (1.f / DM) + EPS);
        }
        asm volatile("s_waitcnt vmcnt(0) lgkmcnt(0)" ::: "memory"); __builtin_amdgcn_s_barrier(); asm volatile("" ::: "memory");
#pragma unroll
        for (int ai = 0; ai < 2; ++ai)
#pragma unroll
            for (int m = 0; m < 4; ++m) {
                const int rl = ai * 128 + wr * 64 + m * 16 + fr;
                const float rs = S[rl];
                float* op = out_real + (size_t)(u.pm * 256 + rl) * DM;
#pragma unroll
                for (int bj = 0; bj < 2; ++bj)
#pragma unroll
                    for (int n = 0; n < 2; ++n) {
                        const int c = col0 + bj * 128 + n * 16;
                        *(f32x4*)(op + c) = acc[ai][bj][m][n] * rs * *(const f32x4*)(gain + c);
                    }
            }
        asm volatile("s_waitcnt lgkmcnt(0)" ::: "memory"); __builtin_amdgcn_s_barrier(); asm volatile("" ::: "memory");
    }
};
struct EpiSwiGLU {
    static constexpr bool PERM = true, AFTER_DRAIN = false;
    bf16_t* ff; const float* ssq;
    __device__ __forceinline__ void operator()(const f32x4 (&acc)[2][2][4][2], const pg8::Unit& u, int wr, int wc, int fr, int fq) const {
        const int row0 = u.pm * 256 + wr * 64 + fr, col0 = u.pn * 128 + wc * 32 + 8 * fq;
#pragma unroll
        for (int ai = 0; ai < 2; ++ai)
#pragma unroll
            for (int m = 0; m < 4; ++m) {
                const int row = row0 + ai * 128 + m * 16;
                const float rs = rsqrtf(ssq[row] * (1.f / DM) + EPS);
                float f[8];
#pragma unroll
                for (int n = 0; n < 2; ++n)
#pragma unroll
                    for (int e = 0; e < 4; ++e) { const float g = acc[ai][0][m][n][e] * rs, up = acc[ai][1][m][n][e] * rs; f[4 * n + e] = silu_f(g) * up; }
                u32x4 w; w.x = pk2(f[0], f[1]); w.y = pk2(f[2], f[3]); w.z = pk2(f[4], f[5]); w.w = pk2(f[6], f[7]);
                *(u32x4*)(ff + (size_t)row * DFF + col0) = w;
            }
    }
};

#define MFMA16(a, b, c) __builtin_amdgcn_mfma_f32_16x16x32_bf16((a), (b), (c), 0, 0, 0)
template <int K> __device__ __forceinline__ f32x4 mini16(const bf16_t* A, int lda, const bf16_t* Bn, int lane) {
    const bf16_t* ap = A + (size_t)(lane & 15) * lda + 8 * (lane >> 4);
    const bf16_t* bp = Bn + (size_t)(lane & 15) * K + 8 * (lane >> 4);
    float z_ = 0.f; asm volatile("" : "+v"(z_));
    f32x4 acc = {z_, z_, z_, z_}, acc2 = {z_, z_, z_, z_};
#pragma unroll 8
    for (int s = 0; s < K / 32; s += 2) {
        const bf16x8 a = *(const bf16x8*)(ap + 32 * s), b = *(const bf16x8*)(bp + 32 * s), a2 = *(const bf16x8*)(ap + 32 * s + 32), b2 = *(const bf16x8*)(bp + 32 * s + 32);
        acc = MFMA16(b, a, acc); acc2 = MFMA16(b2, a2, acc2);
    }
    return acc + acc2;
}
__device__ __forceinline__ float logsig2(float z) { return (fminf(z, 0.f) - log1pf(__expf(-fabsf(z)))) * LOG2E; }
__device__ __forceinline__ void mini_resid(const f32x4 acc, const float* in16, float* hmeta, bf16_t* hb, float* ssq, int t, int lane) {
    const int j = lane & 15, col = 16 * t + 4 * (lane >> 4);
    const f32x4 o = *(const f32x4*)(in16 + (size_t)j * DM + col) + acc;
    *(f32x4*)(hmeta + (size_t)j * DM + col) = o;
    u32x2 w; w.x = pk2(o[0], o[1]); w.y = pk2(o[2], o[3]);
    *(u32x2*)(hb + (size_t)(MR + j) * DM + col) = w;
    float ss = (o[0] * o[0] + o[1] * o[1]) + (o[2] * o[2] + o[3] * o[3]);
    ss += __shfl_xor(ss, 16); ss += __shfl_xor(ss, 32);
    if (lane < 16) (void)__hip_atomic_fetch_add(ssq + MR + j, ss, __ATOMIC_RELAXED, __HIP_MEMORY_SCOPE_AGENT);
}
__device__ __forceinline__ void transpose_item(const float* W, int K, int Nsrc, const float* gain, bf16_t* WT, LAS float* scr, int k0, int n0, int srccol4, int lane, float colscale = 1.f) {
    const int kr = lane >> 3, nq = lane & 7;
#pragma unroll
    for (int i = 0; i < 8; ++i) {
        const int kk = 8 * i + kr;
        f32x4 v = {0.f, 0.f, 0.f, 0.f};
        if (srccol4 >= 0) { v = *(const f32x4*)(W + (size_t)(k0 + kk) * Nsrc + srccol4); if (gain) v = v * (gain[k0 + kk] * colscale); }
        LAS float* d = scr + kk * 33 + 4 * nq;
        d[0] = v[0]; d[1] = v[1]; d[2] = v[2]; d[3] = v[3];
    }
    asm volatile("s_waitcnt lgkmcnt(0)" ::: "memory");
    const int c = lane & 7;
#pragma unroll
    for (int j = 0; j < 4; ++j) {
        const int n = (lane >> 3) + 8 * j; const LAS float* s = scr + (8 * c) * 33 + n;
        u32x4 o; o.x = pk2(s[0 * 33], s[1 * 33]); o.y = pk2(s[2 * 33], s[3 * 33]); o.z = pk2(s[4 * 33], s[5 * 33]); o.w = pk2(s[6 * 33], s[7 * 33]);
        *(u32x4*)(WT + (size_t)(n0 + n) * K + k0 + 8 * c) = o;
    }
    asm volatile("s_waitcnt lgkmcnt(0)" ::: "memory");
}

struct KArgs {
    const float* x; const float* meta; const float* attn_norm; const float* w_in; const float* b_fgate; const float* ret_gn; const float* w_out;
    const float* ffn_norm; const float* w_gate; const float* w_up; const float* w_down; const float* final_norm;
    float* out; unsigned char* ws;
};

typedef const __attribute__((address_space(4))) KArgs* KAp;
__device__ __forceinline__ void prologue(KAp ap, LAS unsigned char* lds, int gw, int NGW, int wave, int lane) {
    KArgs a; a.x = ap->x; a.meta = ap->meta; a.attn_norm = ap->attn_norm; a.w_in = ap->w_in; a.w_out = ap->w_out; a.ffn_norm = ap->ffn_norm; a.w_gate = ap->w_gate; a.w_up = ap->w_up; a.w_down = ap->w_down; a.ws = ap->ws;
    LAS float* scr = (LAS float*)(lds + wave * 16384);
    constexpr int I_IN = 16 * (NPJ / 32), I_OUT = 16 * (DM / 32), I_GU = 16 * (NGU / 32), I_D = (DFF / 64) * (DM / 32), I_L = I_IN + I_OUT + I_GU + I_D;
    for (int it = gw; it < 2 * I_L; it += NGW) {
        const int l = it / I_L; int r = it % I_L;
        if (r < I_IN) {
            const int nblk = NPJ / 32, kb = r / nblk, nb = r % nblk, n0 = 32 * nb, np = n0 + 4 * (lane & 7);
            int sc;
            if (np < 1536) sc = np; else if (np < 3584) sc = np + 8; else if (np < 3592) sc = np - 2048; else sc = -1;
            transpose_item(a.w_in + (size_t)l * DM * 3592, DM, 3592, a.attn_norm + l * DM, (bf16_t*)(a.ws + WS_WIN + l * WIN_SZ), scr, 64 * kb, n0, sc, lane, n0 < 512 ? 0.125f * LOG2E : 1.f);
            continue;
        }
        r -= I_IN;
        if (r < I_OUT) {
            const int nblk = DM / 32, kb = r / nblk, nb = r % nblk, n0 = 32 * nb;
            transpose_item(a.w_out + (size_t)l * DM * DM, DM, DM, nullptr, (bf16_t*)(a.ws + WS_WOUT + l * WOUT_SZ), scr, 64 * kb, n0, n0 + 4 * (lane & 7), lane);
            continue;
        }
        r -= I_OUT;
        if (r < I_GU) {
            const int nblk = NGU / 32, kb = r / nblk, nb = r % nblk, n0 = 32 * nb;
            const int pn = n0 >> 8, bj = (n0 >> 7) & 1, c = (n0 & 127) + 4 * (lane & 7);
            const float* src = (bj ? a.w_up : a.w_gate) + (size_t)l * DM * DFF;
            transpose_item(src, DM, DFF, a.ffn_norm + l * DM, (bf16_t*)(a.ws + WS_WGU + l * WGU_SZ), scr, 64 * kb, n0, 128 * pn + c, lane);
            continue;
        }
        r -= I_GU;
        {
            const int nblk = DM / 32, kb = r / nblk, nb = r % nblk, n0 = 32 * nb;
            transpose_item(a.w_down + (size_t)l * DFF * DM, DFF, DM, nullptr, (bf16_t*)(a.ws + WS_WD + l * WD_SZ), scr, 64 * kb, n0, n0 + 4 * (lane & 7), lane);
        }
    }
    {
        f32x2* cs = (f32x2*)(a.ws + WS_CS);
        for (int i = gw * 64 + lane; i < 2064 * 64; i += NGW * 64) {
            const int t = i >> 6, f = i & 63;
            const float invf = powf(10000.0f, -(float)(2 * f) / 128.0f);
            const float ang = (float)t * invf;
            const double ad = (double)ang;
            const double kq = rint(ad * 0.63661977236758134308);
            double rr = fma(-kq, 1.57079632679489655800e+00, ad); rr = fma(-kq, 6.12323399573676603587e-17, rr);
            const double r2 = rr * rr;
            double sp = -1.0 / 39916800.0; sp = sp * r2 + 1.0 / 362880.0; sp = sp * r2 - 1.0 / 5040.0; sp = sp * r2 + 1.0 / 120.0; sp = sp * r2 - 1.0 / 6.0; sp = sp * r2 + 1.0; sp *= rr;
            double cp = 1.0 / 479001600.0; cp = cp * r2 - 1.0 / 3628800.0; cp = cp * r2 + 1.0 / 40320.0; cp = cp * r2 - 1.0 / 720.0; cp = cp * r2 + 1.0 / 24.0; cp = cp * r2 - 0.5; cp = cp * r2 + 1.0;
            const int q = ((int)kq) & 3;
            const double sv = (q == 0) ? sp : (q == 1) ? cp : (q == 2) ? -sp : -cp;
            const double cv = (q == 0) ? cp : (q == 1) ? -sp : (q == 2) ? -cp : sp;
            cs[i] = (f32x2){(float)cv, (float)sv};
        }
    }
    {
        bf16_t* hb = (bf16_t*)(a.ws + WS_HB); float* ssq = (float*)(a.ws + WS_SSQ);
        for (int row = gw; row < MR + 16; row += NGW) {
            const float* src = row < MR ? a.x + (size_t)row * DM : a.meta + (size_t)(row - MR) * DM;
            f32x4 v[4]; float s = 0.f;
#pragma unroll
            for (int j = 0; j < 4; ++j) { v[j] = *(const f32x4*)(src + 4 * (lane + 64 * j)); s += (v[j][0] * v[j][0] + v[j][1] * v[j][1]) + (v[j][2] * v[j][2] + v[j][3] * v[j][3]); }
            s = wave_sum(s);
#pragma unroll
            for (int j = 0; j < 4; ++j) { u32x2 w; w.x = pk2(v[j][0], v[j][1]); w.y = pk2(v[j][2], v[j][3]); *(u32x2*)(hb + (size_t)row * DM + 4 * (lane + 64 * j)) = w; }
            if (lane == 0) ssq[row] = s;
        }
    }
}

typedef short v4i16_t __attribute__((ext_vector_type(4)));
__device__ __forceinline__ s16x4 vtr(const LAS bf16_t* p) { return __builtin_bit_cast(s16x4, __builtin_amdgcn_ds_read_tr16_b64_v4i16((LAS v4i16_t*)p)); }
__device__ __forceinline__ u32x4 zero4u() { unsigned z = 0u; asm volatile("" : "+v"(z)); return (u32x4){z, z, z, z}; }
__device__ __forceinline__ float max3f(float a, float b, float c) { float r; asm("v_max3_f32 %0, %1, %2, %3" : "=v"(r) : "v"(a), "v"(b), "v"(c)); return r; }
constexpr int FOX_KS = 0, FOX_VS = 36864, FOX_C2 = 73728, FOX_WT = 82432, FOX_STG = 18432;
__device__ __forceinline__ void fox_unit(LAS unsigned char* lds, const bf16_t* __restrict__ proj, const float* __restrict__ lf, bf16_t* __restrict__ mix, int b, int h, int qb) {
    int tid_ = threadIdx.x; asm volatile("" : "+v"(tid_));
    const int tid = tid_, lane = tid & 63, w = __builtin_amdgcn_readfirstlane(tid >> 6), ql = lane & 31, hi = lane >> 5;
    LAS float* C2 = (LAS float*)(lds + FOX_C2); LAS float* WT = (LAS float*)(lds + FOX_WT);
    const bool meta = qb < 0;
    const int NS = meta ? 0 : 2 * (qb + 1);
    const int sq = meta ? 0 : 256 * qb + 32 * w + ql;
    const int wq0 = 256 * qb + 32 * w;
    const size_t qrow = meta ? (size_t)(MR + (ql & 15)) : (size_t)b * SEQ + sq;
    bf16x8 Q[4];
#pragma unroll
    for (int d0 = 0; d0 < 4; ++d0) Q[d0] = *(const bf16x8*)(proj + qrow * PJ + C_FQ + h * 64 + 16 * d0 + 8 * hi);
    const int qpos_meta = meta ? (32 * w + ql) : 100000;
    const int lkv = tid >> 3, lch = tid & 7;
    const int trq = (lane & 15) >> 2, trp = lane & 3, trb = (lane >> 4) & 1;
    const u32x4 zz = zero4u();
    u32x4 kreg0 = zz, kreg1 = zz, vreg0 = zz, vreg1 = zz;
#define FOX_GLOAD(st_) do { const int s__ = (st_); \
        if (s__ == 0) { if (lkv < 16) { const bf16_t* r__ = proj + (size_t)(MR + lkv) * PJ + h * 64 + 8 * lch; kreg0 = *(const u32x4*)(r__ + C_FK); vreg0 = *(const u32x4*)(r__ + C_FV); } else { kreg0 = zz; vreg0 = zz; } } \
        else { const bf16_t* r__ = proj + ((size_t)b * SEQ + 128 * (s__ - 1) + lkv) * PJ + h * 64 + 8 * lch; \
               kreg0 = *(const u32x4*)(r__ + C_FK); vreg0 = *(const u32x4*)(r__ + C_FV); kreg1 = *(const u32x4*)(r__ + (size_t)64 * PJ + C_FK); vreg1 = *(const u32x4*)(r__ + (size_t)64 * PJ + C_FV); } } while (0)
#define FOX_WRITE(st_) do { const int s__ = (st_); LAS bf16_t* kd__ = (LAS bf16_t*)(lds + FOX_KS + (s__ & 1) * FOX_STG) + lkv * 72 + 8 * lch; LAS bf16_t* vd__ = (LAS bf16_t*)(lds + FOX_VS + (s__ & 1) * FOX_STG) + lkv * 72 + 8 * lch; \
        *(LAS u32x4*)kd__ = kreg0; *(LAS u32x4*)vd__ = vreg0; if (s__ > 0) { *(LAS u32x4*)(kd__ + 64 * 72) = kreg1; *(LAS u32x4*)(vd__ + 64 * 72) = vreg1; } } while (0)
    FOX_GLOAD(NS);
    {
        const float* lfr = lf + (size_t)h * MT + (size_t)b * SEQ;
        const float* lfm = lf + (size_t)h * MT + MR;
        const f32x4 v = *(const f32x4*)(lfr + 4 * tid);
        const f32x4 m0 = *(const f32x4*)(lfm), m1 = *(const f32x4*)(lfm + 4), m2 = *(const f32x4*)(lfm + 8), m3 = *(const f32x4*)(lfm + 12);
        const float mv[16] = {m0[0], m0[1], m0[2], m0[3], m1[0], m1[1], m1[2], m1[3], m2[0], m2[1], m2[2], m2[3], m3[0], m3[1], m3[2], m3[3]};
        float mt = 0.f, mpre = 0.f;
#pragma unroll
        for (int j = 0; j < 16; ++j) { mt += mv[j]; if (j <= tid) mpre += mv[j]; }
        if (tid < 16) C2[tid] = -mpre;
        const float p0 = v[0], p1 = p0 + v[1], p2 = p1 + v[2], p3 = p2 + v[3];
        float xs = p3;
#pragma unroll
        for (int o = 1; o < 64; o <<= 1) { const float y = __shfl_up(xs, o); if (lane >= o) xs += y; }
        if (lane == 63) WT[w] = xs;
        __syncthreads();
        float off = mt;
        for (int i = 0; i < w; ++i) off += WT[i];
        off += xs - p3;
        *(LAS f32x4*)(C2 + 16 + 4 * tid) = (f32x4){-(off + p0), -(off + p1), -(off + p2), -(off + p3)};
    }
    f32x16 O0, O1;
#pragma unroll
    for (int r = 0; r < 16; ++r) { O0[r] = 0.f; O1[r] = 0.f; }
    float mrun = -INFINITY;
    f32x16 L;
#pragma unroll
    for (int r = 0; r < 16; ++r) L[r] = 0.f;
    const bf16x8 ones8 = {(short)0x3F80, (short)0x3F80, (short)0x3F80, (short)0x3F80, (short)0x3F80, (short)0x3F80, (short)0x3F80, (short)0x3F80};
    FOX_WRITE(NS);
    __syncthreads();
    if (NS >= 1) FOX_GLOAD(NS - 1);
#define FOX_QK(x0, x1, KB, rbase, pb) do { \
        _Pragma("unroll") for (int g = 0; g < 4; ++g) { \
            const f32x4 c0_ = *(const LAS f32x4*)(C2 + (pb) + 8 * g + 4 * hi), c1_ = *(const LAS f32x4*)(C2 + (pb) + 32 + 8 * g + 4 * hi); \
            _Pragma("unroll") for (int i = 0; i < 4; ++i) { x0[4 * g + i] = c0_[i]; x1[4 * g + i] = c1_[i]; } } \
        _Pragma("unroll") for (int d0 = 0; d0 < 4; ++d0) { \
            const bf16x8 kf0_ = *(const LAS bf16x8*)((KB) + ((rbase) + ql) * 72 + 16 * d0 + 8 * hi), kf1_ = *(const LAS bf16x8*)((KB) + ((rbase) + 32 + ql) * 72 + 16 * d0 + 8 * hi); \
            x0 = MFMA32(kf0_, Q[d0], x0); x1 = MFMA32(kf1_, Q[d0], x1); } \
        asm volatile("s_nop 15\n\ts_nop 7" : "+v"(x0), "+v"(x1));   } while (0)
#define FOX_PV(x0, x1, VB, rbase) do { \
        bf16x8 Pk[4]; \
        Pk[0] = pack8(x0[0], x0[1], x0[2], x0[3], x0[4], x0[5], x0[6], x0[7]); Pk[1] = pack8(x0[8], x0[9], x0[10], x0[11], x0[12], x0[13], x0[14], x0[15]); \
        Pk[2] = pack8(x1[0], x1[1], x1[2], x1[3], x1[4], x1[5], x1[6], x1[7]); Pk[3] = pack8(x1[8], x1[9], x1[10], x1[11], x1[12], x1[13], x1[14], x1[15]); \
        _Pragma("unroll") for (int s = 0; s < 4; ++s) { \
            const LAS bf16_t* vb = (VB) + ((rbase) + 16 * s + 4 * hi + trq) * 72 + 16 * trb + 4 * trp; \
            const s16x4 l0_ = vtr(vb), h0_ = vtr(vb + 8 * 72), l1_ = vtr(vb + 32), h1_ = vtr(vb + 8 * 72 + 32); \
            const bf16x8 va0_ = __builtin_shufflevector(l0_, h0_, 0, 1, 2, 3, 4, 5, 6, 7), va1_ = __builtin_shufflevector(l1_, h1_, 0, 1, 2, 3, 4, 5, 6, 7); \
            O0 = MFMA32(va0_, Pk[s], O0); O1 = MFMA32(va1_, Pk[s], O1); L = MFMA32(ones8, Pk[s], L); } } while (0)
    for (int st = NS; st >= 0; --st) {
        const LAS bf16_t* KB = (const LAS bf16_t*)(lds + FOX_KS + (st & 1) * FOX_STG); const LAS bf16_t* VB = (const LAS bf16_t*)(lds + FOX_VS + (st & 1) * FOX_STG);
        const int jA = 2 * (st - 1);
        const bool actA = (st == 0) || (64 * jA <= wq0 + 31), actB = (st > 0) && (64 * (jA + 1) <= wq0 + 31);
        if (actA) {
            f32x16 a0, a1, b0, b1;
            const int pbA = (st == 0) ? 0 : 16 + 64 * jA;
            FOX_QK(a0, a1, KB, 0, pbA);
            if (st == 0) {
                const int thr = (qpos_meta < 15 ? qpos_meta : 15) - 4 * hi;
#pragma unroll
                for (int r = 0; r < 16; ++r) { if ((r & 3) + 8 * (r >> 2) > thr) a0[r] = -INFINITY; a1[r] = -INFINITY; }
            } else if (64 * jA + 63 > wq0) {
                const int thr = sq - 64 * jA - 4 * hi;
#pragma unroll
                for (int r = 0; r < 16; ++r) { if ((r & 3) + 8 * (r >> 2) > thr) a0[r] = -INFINITY; if (32 + (r & 3) + 8 * (r >> 2) > thr) a1[r] = -INFINITY; }
            }
            float mx = max3f(a0[0], a1[0], a0[1]), mx2 = max3f(a1[1], a0[2], a1[2]);
#pragma unroll
            for (int r = 3; r < 15; r += 2) { mx = max3f(mx, a0[r], a1[r]); mx2 = max3f(mx2, a0[r + 1], a1[r + 1]); }
            mx = max3f(mx, a0[15], a1[15]);
            if (actB) {
                FOX_QK(b0, b1, KB, 64, pbA + 64);
                if (64 * jA + 127 > wq0) {
                    const int thr = sq - 64 * jA - 64 - 4 * hi;
#pragma unroll
                    for (int r = 0; r < 16; ++r) { if ((r & 3) + 8 * (r >> 2) > thr) b0[r] = -INFINITY; if (32 + (r & 3) + 8 * (r >> 2) > thr) b1[r] = -INFINITY; }
                }
#pragma unroll
                for (int r = 0; r < 16; r += 2) { mx = max3f(mx, b0[r], b1[r]); mx2 = max3f(mx2, b0[r + 1], b1[r + 1]); }
            }
            mx = max3f(mx, mx2, mx2);
            if (!__all(mx <= mrun - 40.0f)) {
            mx = fmaxf(mx, __shfl_xor(mx, 32));
            const float mn = fmaxf(mrun, mx);
            const float alpha = ex2(mrun - mn);
            mrun = mn;
#pragma unroll
            for (int r = 0; r < 16; ++r) { a0[r] = ex2(a0[r] - mn); a1[r] = ex2(a1[r] - mn); }
            if (actB) {
#pragma unroll
                for (int r = 0; r < 16; ++r) { b0[r] = ex2(b0[r] - mn); b1[r] = ex2(b1[r] - mn); }
            }
            L[0] *= alpha;
            O0 = O0 * alpha; O1 = O1 * alpha;
            FOX_PV(a0, a1, VB, 0);
            if (actB) FOX_PV(b0, b1, VB, 64);
            }
        }
        if (st >= 1) FOX_WRITE(st - 1);
        __syncthreads();
        if (st >= 2) FOX_GLOAD(st - 2);
    }
#undef FOX_GLOAD
#undef FOX_WRITE
#undef FOX_QK
#undef FOX_PV
    const float inv = 1.0f / L[0];
    if (!meta || (w == 0 && ql < 16)) {
        bf16_t* op = mix + qrow * DM + h * 64;
#pragma unroll
        for (int g = 0; g < 4; ++g) {
            const int d = 8 * g + 4 * hi;
            u32x2 w0, w1;
            w0.x = pk2(O0[4 * g] * inv, O0[4 * g + 1] * inv); w0.y = pk2(O0[4 * g + 2] * inv, O0[4 * g + 3] * inv);
            w1.x = pk2(O1[4 * g] * inv, O1[4 * g + 1] * inv); w1.y = pk2(O1[4 * g + 2] * inv, O1[4 * g + 3] * inv);
            *(u32x2*)(op + d) = w0; *(u32x2*)(op + 32 + d) = w1;
        }
    }
    __syncthreads();
}

constexpr int RET_KI = 0, RET_QI = 34816, RET_ST = 69632, RET_VI = 104448, RET_RED = 141312, RP = 136, RPV = 144;
__device__ __forceinline__ void ret_unit(LAS unsigned char* lds, const bf16_t* __restrict__ proj, const float* __restrict__ gn, bf16_t* __restrict__ mix, int b, int h, int part2) {
    const int c_end = part2 ? 16 : 8, c_full = part2 ? 8 : -1;
    int tid_ = threadIdx.x; asm volatile("" : "+v"(tid_));
    const int tid = tid_, lane = tid & 63, w = __builtin_amdgcn_readfirstlane(tid >> 6), ql = lane & 31, hi = lane >> 5;
    const int qi = w & 3, eh = w >> 2, eB = w >> 1, dB0 = 2 * (w & 1);
    const int trq = (lane & 15) >> 2, trp = lane & 3, trb = (lane >> 4) & 1;
    LAS bf16_t* KI = (LAS bf16_t*)(lds + RET_KI); LAS bf16_t* QI = (LAS bf16_t*)(lds + RET_QI); LAS bf16_t* ST = (LAS bf16_t*)(lds + RET_ST); LAS bf16_t* VI = (LAS bf16_t*)(lds + RET_VI);
    LAS float* RED = (LAS float*)(lds + RET_RED);
    const float lg = log2f(1.0f - ex2(-(float)(5 + h)));
    constexpr float KSC = 0.08838834764831845f;
    const u32x4 zz = zero4u();
    for (int i = tid; i < 34816 / 16; i += 512) *(LAS u32x4*)(lds + RET_ST + 16 * i) = zz;
    f32x16 SA0, SA1;
#pragma unroll
    for (int r = 0; r < 16; ++r) { SA0[r] = 0.f; SA1[r] = 0.f; }
    const int sj = tid >> 2, part = tid & 3;
    const float qs = ex2((float)sj * lg), ks = KSC * ex2(-(float)sj * lg), cdec = ex2(128.f * lg);
    const int slot = 32 * qi + ql;
    u32x4 rq[4], rk[4];
#define RET_GLOAD(c_) do { const int c__ = (c_); \
        const size_t row__ = (c__ >= 0) ? (size_t)b * SEQ + 128 * c__ + sj : (size_t)(MR + (sj >= 112 ? sj - 112 : 0)); \
        const bf16_t* p__ = proj + row__ * PJ + h * 128; \
        rq[0] = *(const u32x4*)(p__ + C_RQ + 16 * part); rq[1] = *(const u32x4*)(p__ + C_RQ + 16 * part + 8); rq[2] = *(const u32x4*)(p__ + C_RQ + 64 + 16 * part); rq[3] = *(const u32x4*)(p__ + C_RQ + 64 + 16 * part + 8); \
        rk[0] = *(const u32x4*)(p__ + C_RK + 16 * part); rk[1] = *(const u32x4*)(p__ + C_RK + 16 * part + 8); rk[2] = *(const u32x4*)(p__ + C_RK + 64 + 16 * part); rk[3] = *(const u32x4*)(p__ + C_RK + 64 + 16 * part + 8); } while (0)
    RET_GLOAD(-1);
    for (int c = -1; c < c_end; ++c) {
        const bool full = c >= c_full;
        {
            const bool valid = (c >= 0) || (sj >= 112);
            const float tpos = (float)((c >= 0) ? 16 + 128 * c + sj : (sj >= 112 ? sj - 112 : 0));
            u32x4 rv[4];
            { const size_t vrow = (c >= 0) ? (size_t)b * SEQ + 128 * c + sj : (size_t)(MR + (sj >= 112 ? sj - 112 : 0)); const bf16_t* vp = proj + vrow * PJ + C_RV + h * 128 + 32 * part;
#pragma unroll
              for (int q4 = 0; q4 < 4; ++q4) rv[q4] = *(const u32x4*)(vp + 8 * q4); }
#pragma unroll
            for (int hf = 0; hf < 2; ++hf) {
                float q1[8], q2[8], k1[8], k2[8];
#pragma unroll
                for (int e2 = 0; e2 < 4; ++e2) {
                    const unsigned uq1 = rq[hf][e2], uq2 = rq[2 + hf][e2], uk1 = rk[hf][e2], uk2 = rk[2 + hf][e2];
#pragma unroll
                    for (int o = 0; o < 2; ++o) {
                        const int e = 2 * e2 + o, pi = 16 * part + 8 * hf + e;
                        const float invf = ex2(-(float)pi * 0.20762050593046014f);
                        const float ang = tpos * invf;
                        const float fr = __builtin_amdgcn_fractf(ang * 0.15915494309189535f);
                        const float cc = __builtin_amdgcn_cosf(fr), sn = __builtin_amdgcn_sinf(fr);
                        const float a = o ? bfhi(uq1) : bflo(uq1), bb = o ? bfhi(uq2) : bflo(uq2), ka = o ? bfhi(uk1) : bflo(uk1), kb = o ? bfhi(uk2) : bflo(uk2);
                        q1[e] = (a * cc - bb * sn) * qs; q2[e] = (a * sn + bb * cc) * qs;
                        k1[e] = (ka * cc - kb * sn) * ks; k2[e] = (ka * sn + kb * cc) * ks;
                    }
                }
                if (!valid) {
#pragma unroll
                    for (int e = 0; e < 8; ++e) { q1[e] = 0.f; q2[e] = 0.f; k1[e] = 0.f; k2[e] = 0.f; }
                }
                if (full) {
                    *(LAS bf16x8*)(QI + sj * RP + 16 * part + 8 * hf) = pack8(q1[0], q1[1], q1[2], q1[3], q1[4], q1[5], q1[6], q1[7]);
                    *(LAS bf16x8*)(QI + sj * RP + 64 + 16 * part + 8 * hf) = pack8(q2[0], q2[1], q2[2], q2[3], q2[4], q2[5], q2[6], q2[7]);
                }
                *(LAS bf16x8*)(KI + sj * RP + 16 * part + 8 * hf) = pack8(k1[0], k1[1], k1[2], k1[3], k1[4], k1[5], k1[6], k1[7]);
                *(LAS bf16x8*)(KI + sj * RP + 64 + 16 * part + 8 * hf) = pack8(k2[0], k2[1], k2[2], k2[3], k2[4], k2[5], k2[6], k2[7]);
            }
#pragma unroll
            for (int q4 = 0; q4 < 4; ++q4) *(LAS u32x4*)(VI + sj * RPV + 32 * part + 8 * q4) = valid ? rv[q4] : zz;
        }
        __syncthreads();
        if (c + 1 < c_end) RET_GLOAD(c + 1);
        const bool qvalid = (c >= 0) || (slot >= 112 && b == 0);
        const size_t qrow = (c >= 0) ? (size_t)b * SEQ + 128 * c + slot : (size_t)(MR + (slot >= 112 ? slot - 112 : 0));
        f32x16 O0, O1;
#pragma unroll
        for (int r = 0; r < 16; ++r) { O0[r] = 0.f; O1[r] = 0.f; }
        if (full) {
        bf16x8 Qr[8];
#pragma unroll
        for (int d0 = 0; d0 < 8; ++d0) Qr[d0] = *(const LAS bf16x8*)(QI + slot * RP + 16 * d0 + 8 * hi);
#pragma unroll
        for (int d0 = 0; d0 < 8; ++d0) {
            const bf16x8 s0 = *(const LAS bf16x8*)(ST + (64 * eh + ql) * RP + 16 * d0 + 8 * hi), s1 = *(const LAS bf16x8*)(ST + (64 * eh + 32 + ql) * RP + 16 * d0 + 8 * hi);
            O0 = MFMA32(s0, Qr[d0], O0); O1 = MFMA32(s1, Qr[d0], O1);
        }
#pragma unroll
        for (int r = 0; r < 16; ++r) { O0[r] *= cdec; O1[r] *= cdec; }
        for (int jb = 0; jb <= qi; ++jb) {
            f32x16 sT;
#pragma unroll
            for (int r = 0; r < 16; ++r) sT[r] = 0.f;
#pragma unroll
            for (int d0 = 0; d0 < 8; ++d0) { const bf16x8 ka = *(const LAS bf16x8*)(KI + (32 * jb + ql) * RP + 16 * d0 + 8 * hi); sT = MFMA32(ka, Qr[d0], sT); }
            if (jb == qi) {
#pragma unroll
                for (int r = 0; r < 16; ++r) if (crow(r, hi) > ql) sT[r] = 0.f;
            }
            bf16x8 Pk[2];
            Pk[0] = pack8(sT[0], sT[1], sT[2], sT[3], sT[4], sT[5], sT[6], sT[7]);
            Pk[1] = pack8(sT[8], sT[9], sT[10], sT[11], sT[12], sT[13], sT[14], sT[15]);
#pragma unroll
            for (int s = 0; s < 2; ++s) {
                const LAS bf16_t* vb = VI + (32 * jb + 16 * s + 4 * hi + trq) * RPV + 64 * eh + 16 * trb + 4 * trp;
                const s16x4 l0 = vtr(vb), h0 = vtr(vb + 8 * RPV), l1 = vtr(vb + 32), h1 = vtr(vb + 8 * RPV + 32);
                const bf16x8 va0 = __builtin_shufflevector(l0, h0, 0, 1, 2, 3, 4, 5, 6, 7), va1 = __builtin_shufflevector(l1, h1, 0, 1, 2, 3, 4, 5, 6, 7);
                O0 = MFMA32(va0, Pk[s], O0); O1 = MFMA32(va1, Pk[s], O1);
            }
        }
        }
#pragma unroll
        for (int r = 0; r < 16; ++r) { SA0[r] *= cdec; SA1[r] *= cdec; }
#pragma unroll
        for (int js = 0; js < 8; ++js) {
            const LAS bf16_t* vb = VI + (16 * js + 8 * hi + trq) * RPV + 32 * eB + 16 * trb + 4 * trp;
            const LAS bf16_t* kb = KI + (16 * js + 8 * hi + trq) * RP + 32 * dB0 + 16 * trb + 4 * trp;
            const s16x4 vl = vtr(vb), vh = vtr(vb + 4 * RPV), k0l = vtr(kb), k0h = vtr(kb + 4 * RP), k1l = vtr(kb + 32), k1h = vtr(kb + 4 * RP + 32);
            const bf16x8 va = __builtin_shufflevector(vl, vh, 0, 1, 2, 3, 4, 5, 6, 7);
            const bf16x8 k0 = __builtin_shufflevector(k0l, k0h, 0, 1, 2, 3, 4, 5, 6, 7), k1 = __builtin_shufflevector(k1l, k1h, 0, 1, 2, 3, 4, 5, 6, 7);
            SA0 = MFMA32(va, k0, SA0); SA1 = MFMA32(va, k1, SA1);
        }
        if (!full) {
            __syncthreads();
            if (c + 1 >= c_full) {
#pragma unroll
                for (int r = 0; r < 16; ++r) {
                    ST[(32 * eB + crow(r, hi)) * RP + 32 * dB0 + ql] = (bf16_t)(pk2(SA0[r], 0.f) & 0xffffu);
                    ST[(32 * eB + crow(r, hi)) * RP + 32 * dB0 + 32 + ql] = (bf16_t)(pk2(SA1[r], 0.f) & 0xffffu);
                }
            }
            continue;
        }
        float s1 = 0.f, s2 = 0.f;
#pragma unroll
        for (int r = 0; r < 16; ++r) { s1 += O0[r] + O1[r]; s2 += O0[r] * O0[r] + O1[r] * O1[r]; }
        s1 += __shfl_xor(s1, 32); s2 += __shfl_xor(s2, 32);
        asm volatile("" ::: "memory");
        u32x2 ga[4], gb[4];
        {
            const bf16_t* gp = proj + qrow * PJ + C_RG + h * 128 + 64 * eh;
#pragma unroll
            for (int g = 0; g < 4; ++g) { ga[g] = *(const u32x2*)(gp + 8 * g + 4 * hi); gb[g] = *(const u32x2*)(gp + 32 + 8 * g + 4 * hi); }
        }
        __syncthreads();
#pragma unroll
        for (int r = 0; r < 16; ++r) {
            ST[(32 * eB + crow(r, hi)) * RP + 32 * dB0 + ql] = (bf16_t)(pk2(SA0[r], 0.f) & 0xffffu);
            ST[(32 * eB + crow(r, hi)) * RP + 32 * dB0 + 32 + ql] = (bf16_t)(pk2(SA1[r], 0.f) & 0xffffu);
        }
        if (hi == 0) { RED[(eh * 128 + slot) * 2] = s1; RED[(eh * 128 + slot) * 2 + 1] = s2; }
        __syncthreads();
        {
            const float t1 = RED[slot * 2] + RED[(128 + slot) * 2], t2 = RED[slot * 2 + 1] + RED[(128 + slot) * 2 + 1];
            const float mu = t1 * (1.f / 128.f), var = fmaxf(t2 * (1.f / 128.f) - mu * mu, 0.f), rstd = rsqrtf(var + EPS);
            if (qvalid) {
                bf16_t* op = mix + qrow * DM + 512 + h * 128 + 64 * eh; const float* gg = gn + h * 128 + 64 * eh;
#pragma unroll
                for (int g = 0; g < 4; ++g) {
                    const int e0 = 8 * g + 4 * hi;
                    const f32x4 na = *(const f32x4*)(gg + e0), nb = *(const f32x4*)(gg + 32 + e0);
                    const float y0 = (O0[4 * g] - mu) * rstd * na[0] * silu_f(bflo(ga[g].x)), y1 = (O0[4 * g + 1] - mu) * rstd * na[1] * silu_f(bfhi(ga[g].x));
                    const float y2 = (O0[4 * g + 2] - mu) * rstd * na[2] * silu_f(bflo(ga[g].y)), y3 = (O0[4 * g + 3] - mu) * rstd * na[3] * silu_f(bfhi(ga[g].y));
                    const float z0 = (O1[4 * g] - mu) * rstd * nb[0] * silu_f(bflo(gb[g].x)), z1 = (O1[4 * g + 1] - mu) * rstd * nb[1] * silu_f(bfhi(gb[g].x));
                    const float z2 = (O1[4 * g + 2] - mu) * rstd * nb[2] * silu_f(bflo(gb[g].y)), z3 = (O1[4 * g + 3] - mu) * rstd * nb[3] * silu_f(bfhi(gb[g].y));
                    u32x2 wa, wb; wa.x = pk2(y0, y1); wa.y = pk2(y2, y3); wb.x = pk2(z0, z1); wb.y = pk2(z2, z3);
                    *(u32x2*)(op + e0) = wa; *(u32x2*)(op + 32 + e0) = wb;
                }
            }
        }
    }
#undef RET_GLOAD
    __syncthreads();
}
#define XB_TMO      128
#define XB_XCNT(j)  (256  + 64 * (j))
#define XB_XSUB(j)  (1280 + 64 * (j))
#define XB_XGEN(j)  (2304 + 64 * (j))
#define XB_TOP      3328
#define XB_TOPGEN   3392
#define XCD_BAR_WORDS 3456
#define XB_SPIN_CAP (1u << 18)

__device__ __forceinline__ unsigned xb_ld(unsigned* p)              { return __hip_atomic_load(p, __ATOMIC_RELAXED, __HIP_MEMORY_SCOPE_AGENT); }
__device__ __forceinline__ unsigned xb_add(unsigned* p, unsigned v) { return __hip_atomic_fetch_add(p, v, __ATOMIC_RELAXED, __HIP_MEMORY_SCOPE_AGENT); }
__device__ __forceinline__ unsigned xb_xcc_id() { return (unsigned)__builtin_amdgcn_s_getreg((3 << 11) | 20) & 0xFu; }
#define XB_SPIN(cond, bar) do { unsigned _sp = 0; while (cond) { __builtin_amdgcn_s_sleep(1); \
    if ((++_sp & 255u) == 0u) { if (xb_ld(&(bar)[XB_TMO])) break; if (_sp > XB_SPIN_CAP) { atomicAdd(&(bar)[XB_TMO], 1u); break; } } } } while (0)

struct XcdBarrier {
    unsigned* bar; unsigned x;
    volatile LAS unsigned* st;
};

__device__ __forceinline__ XcdBarrier xcd_barrier_post(unsigned* bar, volatile LAS unsigned* st) {
    XcdBarrier b; b.bar = bar; b.x = xb_xcc_id(); b.st = st;
    if (threadIdx.x == 0) (void)xb_add(&bar[XB_XCNT(b.x)], 1u);
    return b;
}
__device__ __forceinline__ void xcd_barrier_complete(unsigned* bar, unsigned x, unsigned& nloc, unsigned& nx) {
    const unsigned G = gridDim.x * gridDim.y * gridDim.z;
    unsigned sum, cnt, mine, sp = 0u;
    for (;;) {
        sum = 0u; cnt = 0u; mine = 0u;
#pragma unroll
        for (unsigned j = 0; j < 16; ++j) { const unsigned c = xb_ld(&bar[XB_XCNT(j)]); sum += c; cnt += (c > 0u) ? 1u : 0u; mine = (j == x) ? c : mine; }
        if (sum == G) break;
        __builtin_amdgcn_s_sleep(1);
        if ((++sp & 255u) == 0u) { if (xb_ld(&bar[XB_TMO])) break; if (sp > XB_SPIN_CAP) { atomicAdd(&bar[XB_TMO], 1u); break; } }
    }
    nloc = mine > 0u ? mine : 1u; nx = cnt > 0u ? cnt : 1u;
}

__device__ __forceinline__ void xcd_barrier(const XcdBarrier& b) {
    asm volatile("s_waitcnt vmcnt(0)" ::: "memory");
    __syncthreads();
    if (threadIdx.x == 0) {
        unsigned* bar = b.bar;
        __builtin_amdgcn_s_waitcnt(0);
        unsigned nloc = b.st[0], nx = b.st[1];
        if (nloc == 0u) { xcd_barrier_complete(bar, b.x, nloc, nx); b.st[0] = nloc; b.st[1] = nx; }
        const unsigned old = xb_add(&bar[XB_XSUB(b.x)], 1u);
        const unsigned gen = old / nloc;
        if (old + 1u == (gen + 1u) * nloc) {
            __builtin_amdgcn_fence(__ATOMIC_RELEASE, "agent");
            asm volatile("s_waitcnt vmcnt(0)" ::: "memory");
            const unsigned og = xb_add(&bar[XB_TOP], 1u);
            const unsigned tg = og / nx;
            if (og + 1u == (tg + 1u) * nx) xb_add(&bar[XB_TOPGEN], 1u);
            else XB_SPIN(xb_ld(&bar[XB_TOPGEN]) == tg, bar);
            __builtin_amdgcn_fence(__ATOMIC_ACQUIRE, "agent");
            xb_add(&bar[XB_XGEN(b.x)], 1u);
            asm volatile("s_waitcnt vmcnt(0)" ::: "memory");
        } else {
            XB_SPIN(xb_ld(&bar[XB_XGEN(b.x)]) == gen, bar);
            __builtin_amdgcn_fence(__ATOMIC_ACQUIRE, "agent");
            asm volatile("s_waitcnt vmcnt(0)" ::: "memory");
        }
    }
    __syncthreads();
}

constexpr int Q_RET = NB * 4 * 2, Q_FOX = NB * 8 * 8, Q_META = 8, Q_ITEMS = Q_RET + Q_FOX + Q_META;
constexpr int LDS_ITEM = 147200, LDS_XB = 147216;
constexpr int CW_BAR = 4096;
__device__ __forceinline__ KAp kargs() { KAp p = (KAp)__builtin_amdgcn_kernarg_segment_ptr(); asm volatile("" : "+s"(p)); return p; }
__global__ void __launch_bounds__(512) hymba_fwd(KArgs a_unused) {
    extern __shared__ __attribute__((aligned(16))) unsigned char lds_raw[];
    LAS unsigned char* lds = (LAS unsigned char*)lds_raw;
    cg::grid_group grid = cg::this_grid();
    if (threadIdx.x < 2) ((volatile LAS unsigned*)(lds + LDS_XB))[threadIdx.x] = 0u;
    __syncthreads();
    (void)xcd_barrier_post((unsigned*)(kargs()->ws + WS_CTL) + CW_BAR, (volatile LAS unsigned*)(lds + LDS_XB));
#define GRID_BAR() do { XcdBarrier xb__; xb__.bar = (unsigned*)(kargs()->ws + WS_CTL) + CW_BAR; xb__.x = xb_xcc_id(); xb__.st = (volatile LAS unsigned*)(lds + LDS_XB); xcd_barrier(xb__); } while (0)
#define TID ((int)threadIdx.x)
#define LANE (TID & 63)
#define WAVE (__builtin_amdgcn_readfirstlane(TID >> 6))
#define GW ((int)blockIdx.x * 8 + WAVE)
#define NGW_ ((int)gridDim.x * 8)
    {
        KAp a = kargs();
        prologue(a, lds, GW, NGW_, WAVE, LANE);
    }
    if (gridDim.y == 0xFFFFu) grid.sync();
    GRID_BAR();

    for (int l = 0; l < 2; ++l) {
        {
            KAp ka = kargs(); unsigned char* ws = ka->ws;
            const bf16_t* hb = (const bf16_t*)(ws + WS_HB); const bf16_t* win = (const bf16_t*)(ws + WS_WIN + l * WIN_SZ);
            const float* ssq = (const float*)(ws + WS_SSQ) + (size_t)(2 * l) * MT; const float* bfg = ka->b_fgate + l * 8; float* lf = (float*)(ws + WS_LF); bf16_t* proj = (bf16_t*)(ws + WS_PROJ);
            int lane_ = LANE; asm volatile("" : "+v"(lane_)); const int lane = lane_, fq = lane >> 4;
            for (int t = GW; t < MR / 16 + 225; t += NGW_) {
                const bool real = t < MR / 16; const int mt = t - MR / 16;
                const bf16_t* A = hb + (size_t)(real ? 16 * t : MR) * DM; const bf16_t* Bn = win + (size_t)(real || mt == 224 ? 3584 : 16 * mt) * DM;
                const f32x4 acc = mini16<DM>(A, DM, Bn, lane);
                const int row = (real ? 16 * t : MR) + (lane & 15);
                const float rs = rsqrtf(ssq[row] * (1.f / DM) + EPS);
                if (real || mt == 224) {
                    if (fq < 2) {
#pragma unroll
                        for (int r = 0; r < 4; ++r) { const int hh = 4 * fq + r; lf[(size_t)hh * MT + row] = logsig2(acc[r] * rs + bfg[hh]); }
                    }
                } else {
                    u32x2 w; w.x = pk2(acc[0] * rs, acc[1] * rs); w.y = pk2(acc[2] * rs, acc[3] * rs);
                    *(u32x2*)(proj + (size_t)row * PJ + 16 * mt + 4 * fq) = w;
                }
            }
        }
        {
            KAp ka = kargs(); unsigned char* ws = ka->ws;
            pg8::Gemm g{(const bf16_t*)(ws + WS_HB), (const bf16_t*)(ws + WS_WIN + l * WIN_SZ), MR, PJ, DM}; pg8::StaticOrder S; S.init(MR, PJ, (int)gridDim.x, (int)blockIdx.x);
            EpiInProj E{(bf16_t*)(ws + WS_PROJ), (const float*)(ws + WS_SSQ) + (size_t)(2 * l) * MT};
            pg8::gemm_phase<EpiInProj, pg8::StaticOrder, PG8_ALIGN, PG8_SP2, DM>(lds, g, S, E);
        }
        GRID_BAR();
        {
            volatile LAS int* ITEM = (volatile LAS int*)(lds + LDS_ITEM);
            for (;;) {
                KAp ka = kargs(); unsigned char* ws = ka->ws;
                if (TID == 0) *ITEM = (int)__hip_atomic_fetch_add((unsigned*)(ws + WS_CTL) + 64 * l, 1u, __ATOMIC_RELAXED, __HIP_MEMORY_SCOPE_AGENT);
                __syncthreads();
                const int it = __builtin_amdgcn_readfirstlane(*ITEM);
                if (it >= (l == 0 ? Q_ITEMS : Q_ITEMS - Q_META)) break;
                const bf16_t* proj = (const bf16_t*)(ws + WS_PROJ); bf16_t* mix = (bf16_t*)(ws + WS_MIX);
                if (it < Q_RET) ret_unit(lds, proj, ka->ret_gn + l * 512, mix, (it & 63) >> 2, it & 3, it < 64 ? 1 : 0);
                else { const int k = it - Q_RET; fox_unit(lds, proj, (const float*)(ws + WS_LF), mix, (k & 127) >> 3, k & 7, 7 - (k >> 7)); }
            }
        }
        GRID_BAR();
        {
            KAp ka = kargs(); unsigned char* ws = ka->ws; float* out = ka->out; float* hmeta = (float*)(ws + WS_HMETA);
            const bf16_t* mixp = (const bf16_t*)(ws + WS_MIX); const bf16_t* wo = (const bf16_t*)(ws + WS_WOUT + l * WOUT_SZ); bf16_t* hb = (bf16_t*)(ws + WS_HB);
            float* ssq = (float*)(ws + WS_SSQ) + (size_t)(2 * l + 1) * MT;
            int lane_ = LANE; asm volatile("" : "+v"(lane_)); const int lane = lane_;
            if (l == 0)
            for (int t = GW; t < DM / 16; t += NGW_) {
                const f32x4 acc = mini16<DM>(mixp + (size_t)MR * DM, DM, wo + (size_t)16 * t * DM, lane);
                mini_resid(acc, l == 0 ? ka->meta : (const float*)hmeta, hmeta, hb, ssq, t, lane);
            }
        }
        {
            KAp ka = kargs(); unsigned char* ws = ka->ws; float* out = ka->out;
            pg8::Gemm g{(const bf16_t*)(ws + WS_MIX), (const bf16_t*)(ws + WS_WOUT + l * WOUT_SZ), MR, DM, DM}; pg8::StaticOrder S; S.init(MR, DM, (int)gridDim.x, (int)blockIdx.x);
            EpiResid E{(const float*)nullptr, (bf16_t*)(ws + WS_HB), (float*)(ws + WS_SSQ) + (size_t)(2 * l + 1) * MT};
            pg8::gemm_phase<EpiResid, pg8::StaticOrder, PG8_ALIGN, PG8_SP2, DM>(lds, g, S, E);
        }
        GRID_BAR();
        {
            KAp ka = kargs(); unsigned char* ws = ka->ws;
            const bf16_t* hb = (const bf16_t*)(ws + WS_HB); const bf16_t* wgu = (const bf16_t*)(ws + WS_WGU + l * WGU_SZ); bf16_t* ff = (bf16_t*)(ws + WS_PROJ);
            const float* ssq = (const float*)(ws + WS_SSQ) + (size_t)(2 * l + 1) * MT;
            int lane_ = LANE; asm volatile("" : "+v"(lane_)); const int lane = lane_;
            if (l == 0)
            for (int t = GW; t < DFF / 16; t += NGW_) {
                const int f0 = 16 * t, nr = 256 * (f0 >> 7) + (f0 & 127);
                const f32x4 ag = mini16<DM>(hb + (size_t)MR * DM, DM, wgu + (size_t)nr * DM, lane), au = mini16<DM>(hb + (size_t)MR * DM, DM, wgu + (size_t)(nr + 128) * DM, lane);
                const int j = lane & 15; const float rs = rsqrtf(ssq[MR + j] * (1.f / DM) + EPS);
                u32x2 w; w.x = pk2(silu_f(ag[0] * rs) * (au[0] * rs), silu_f(ag[1] * rs) * (au[1] * rs)); w.y = pk2(silu_f(ag[2] * rs) * (au[2] * rs), silu_f(ag[3] * rs) * (au[3] * rs));
                *(u32x2*)(ff + (size_t)(MR + j) * DFF + f0 + 4 * (lane >> 4)) = w;
            }
        }
        {
            KAp ka = kargs(); unsigned char* ws = ka->ws;
            pg8::Gemm g{(const bf16_t*)(ws + WS_HB), (const bf16_t*)(ws + WS_WGU + l * WGU_SZ), MR, NGU, DM}; pg8::StaticOrder S; S.init(MR, NGU, (int)gridDim.x, (int)blockIdx.x);
            EpiSwiGLU E{(bf16_t*)(ws + WS_PROJ), (const float*)(ws + WS_SSQ) + (size_t)(2 * l + 1) * MT};
            pg8::gemm_phase<EpiSwiGLU, pg8::StaticOrder, PG8_ALIGN, PG8_SP2, DM>(lds, g, S, E);
        }
        GRID_BAR();
        {
            KAp ka = kargs(); unsigned char* ws = ka->ws; float* out = ka->out; float* hmeta = (float*)(ws + WS_HMETA);
            const bf16_t* ff = (const bf16_t*)(ws + WS_PROJ); const bf16_t* wd = (const bf16_t*)(ws + WS_WD + l * WD_SZ); bf16_t* hb = (bf16_t*)(ws + WS_HB);
            float* ssq = (float*)(ws + WS_SSQ) + (size_t)(2 * l + 2) * MT;
            int lane_ = LANE; asm volatile("" : "+v"(lane_)); const int lane = lane_;
            if (l == 0)
            for (int t = GW; t < DM / 16; t += NGW_) {
                const f32x4 acc = mini16<DFF>(ff + (size_t)MR * DFF, DFF, wd + (size_t)16 * t * DFF, lane);
                mini_resid(acc, (const float*)hmeta, hmeta, hb, ssq, t, lane);
            }
        }
        if (l == 0) {
            KAp ka = kargs(); unsigned char* ws = ka->ws; float* out = ka->out;
            pg8::Gemm g{(const bf16_t*)(ws + WS_PROJ), (const bf16_t*)(ws + WS_WD + l * WD_SZ), MR, DM, DFF}; pg8::StaticOrder S; S.init(MR, DM, (int)gridDim.x, (int)blockIdx.x);
            EpiResid E{(const float*)nullptr, (bf16_t*)(ws + WS_HB), (float*)(ws + WS_SSQ) + (size_t)(2 * l + 2) * MT};
            pg8::gemm_phase<EpiResid, pg8::StaticOrder, PG8_ALIGN, PG8_SP2, DFF>(lds, g, S, E);
            GRID_BAR();
        } else {
            KAp ka = kargs(); unsigned char* ws = ka->ws; float* out = ka->out;
            pg8::Gemm g{(const bf16_t*)(ws + WS_PROJ), (const bf16_t*)(ws + WS_WD + l * WD_SZ), MR, DM, DFF}; pg8::StaticOrder S; S.init(MR, DM, (int)gridDim.x, (int)blockIdx.x);
            EpiResidNorm E{(const bf16_t*)(ws + WS_HB), out, ka->final_norm, (float*)(ws + WS_XBUF), (unsigned*)(ws + WS_CTL) + CW_CNT, lds + LDS_XCH};
            pg8::gemm_phase<EpiResidNorm, pg8::StaticOrder, true, PG8_SP2, DFF>(lds, g, S, E);
        }
    }
}

extern "C" void kernel_launch(void* const* d_in, const int* in_sizes, int n_in, void* d_out, int out_size, void* d_ws, size_t ws_size, hipStream_t stream) {
    static int grid = 0;
    if (grid == 0) {
        if (n_in != 12 || in_sizes[0] != MR * DM || out_size != MR * DM || ws_size < WS_END) { fprintf(stderr, "kernel_launch: unexpected shapes (n_in %d, in0 %d, out %d, ws %zu)\n", n_in, n_in > 0 ? in_sizes[0] : -1, out_size, ws_size); grid = -1; return; }
        int dev = 0, cus = 0, per_cu = 0;
        if (hipGetDevice(&dev) != hipSuccess || hipDeviceGetAttribute(&cus, hipDeviceAttributeMultiprocessorCount, dev) != hipSuccess) { grid = -1; return; }
        if (hipFuncSetAttribute((const void*)hymba_fwd, hipFuncAttributeMaxDynamicSharedMemorySize, LDS_BYTES) != hipSuccess) { fprintf(stderr, "kernel_launch: hipFuncSetAttribute failed\n"); grid = -1; return; }
        if (hipOccupancyMaxActiveBlocksPerMultiprocessor(&per_cu, (const void*)hymba_fwd, 512, LDS_BYTES) != hipSuccess || per_cu < 1) { fprintf(stderr, "kernel_launch: occupancy query reports %d blocks per CU\n", per_cu); grid = -1; return; }
        (void)hipGetLastError();
        grid = cus;
    }
    if (grid < 0) return;
    if (hipMemsetAsync((char*)d_ws + WS_CTL, 0, CTL_BYTES, stream) != hipSuccess) { fprintf(stderr, "kernel_launch: memset failed\n"); return; }
    KArgs a{};
    a.x = (const float*)d_in[0]; a.meta = (const float*)d_in[1]; a.attn_norm = (const float*)d_in[2]; a.w_in = (const float*)d_in[3]; a.b_fgate = (const float*)d_in[4];
    a.ret_gn = (const float*)d_in[5]; a.w_out = (const float*)d_in[6]; a.ffn_norm = (const float*)d_in[7]; a.w_gate = (const float*)d_in[8]; a.w_up = (const float*)d_in[9];
    a.w_down = (const float*)d_in[10]; a.final_norm = (const float*)d_in[11]; a.out = (float*)d_out; a.ws = (unsigned char*)d_ws;
    void* args[] = {&a};
    const hipError_t e = hipLaunchCooperativeKernel((const void*)hymba_fwd, dim3(grid), dim3(512), args, LDS_BYTES, stream);
    if (e != hipSuccess) fprintf(stderr, "kernel_launch: cooperative launch failed: %s (grid %d)\n", hipGetErrorString(e), grid);
}
```
